# Optimizing an MI355X kernel written in HIP

```python
import math
import jax
import jax.numpy as jnp
from jax import lax
import numpy as np

D_MODEL = 1024
BATCH = 8
SEQ = 2048
DEPTH = 4

HEAD_DIM = 64
CONV_CH = 512
CONV_K = 3
FOX_HEADS = 8
FOX_WIDTH = FOX_HEADS * HEAD_DIM
EVEN_IN = 3 * CONV_CH + 3 * FOX_WIDTH + FOX_HEADS
Q_BLOCK = 128
NSA_GROUPS = 4
NSA_HPG = 4
NSA_HEADS = NSA_GROUPS * NSA_HPG
NSA_WIDTH = NSA_HEADS * HEAD_DIM
NSA_KV = NSA_GROUPS * HEAD_DIM
CMP_LEN = 32
CMP_STRIDE = 16
SLC_LEN = 64
SLC_TOPN = 16
WINDOW = 512
SLC_QCHUNK = 16
ODD_IN = NSA_WIDTH + 6 * NSA_KV + 3 * NSA_HEADS
REL_BUCKETS = 32
REL_MAX_DIST = 128
PEER_HEADS = 8
PEER_NKEYS = 128
PEER_EXPERTS = PEER_NKEYS * PEER_NKEYS
PEER_QDIM = 128
PEER_TOPK = 16
PEER_CHUNK = 128
N_EVEN = (DEPTH + 1) // 2
N_ODD = DEPTH // 2
EPS = 1e-6
NEG_INF = -1e30
FORCE_SCORE = 1e6

kernel_name = 'hybrid_conv_fox_nsa_peer_block'


def rms_norm(x, g):
    xf = x.astype(jnp.float32)
    y = xf * lax.rsqrt(jnp.mean(xf * xf, axis=-1, keepdims=True) + EPS)
    return (y * g.astype(jnp.float32)).astype(x.dtype)


def modulate(h, shift, scale):
    return h * (1 + scale[:, None, :]) + shift[:, None, :]


def masked_softmax(s, mask):
    s = jnp.where(mask, s.astype(jnp.float32), NEG_INF)
    return jax.nn.softmax(s, axis=-1) * mask


def rel_bucket(dist):
    n = jnp.maximum(dist, 0)
    max_exact = REL_BUCKETS // 2
    nf = jnp.maximum(n, 1).astype(jnp.float32)
    large = max_exact + (jnp.log(nf / max_exact) / math.log(REL_MAX_DIST / max_exact)
                         * (REL_BUCKETS - max_exact)).astype(jnp.int32)
    large = jnp.minimum(large, REL_BUCKETS - 1)
    return jnp.where(n < max_exact, n, large)


def short_conv(u, w):
    return lax.conv_general_dilated(
        u, w.astype(u.dtype)[:, None, :], window_strides=(1,), padding=((CONV_K - 1, 0),),
        dimension_numbers=('NWC', 'WIO', 'NWC'), feature_group_count=u.shape[-1])


def fox_attention(q, k, v, logf):
    B, S, H, Dh = q.shape
    nb = S // Q_BLOCK
    cum_t = jnp.cumsum(logf, axis=1).transpose(0, 2, 1)
    kpos = jnp.arange(S)
    scale = Dh ** -0.5
    qb = q.reshape(B, nb, Q_BLOCK, H, Dh).swapaxes(0, 1)
    cb = cum_t.reshape(B, H, nb, Q_BLOCK).transpose(2, 0, 1, 3)
    tb = kpos.reshape(nb, Q_BLOCK)

    def block(args):
        qi, ci, ti = args
        s = jnp.einsum('bqhd,bkhd->bhqk', qi, k).astype(jnp.float32) * scale
        s = s + (ci[..., None] - cum_t[:, :, None, :])
        p = masked_softmax(s, ti[:, None] >= kpos[None, :])
        return jnp.einsum('bhqk,bkhd->bqhd', p.astype(v.dtype), v)

    out = lax.map(block, (qb, cb, tb))
    return out.swapaxes(0, 1).reshape(B, S, H, Dh)


def conv_fox_mixer(h, w_in, b_f, conv_w, q_g, k_g, w_out):
    B, S, _ = h.shape
    splits = list(np.cumsum([CONV_CH] * 3 + [FOX_WIDTH] * 3))
    cb, cc, ch, q, k, v, f = jnp.split(h @ w_in, splits, axis=-1)
    conv_out = cb * short_conv(cc * ch, conv_w)
    q = rms_norm(q.reshape(B, S, FOX_HEADS, HEAD_DIM), q_g)
    k = rms_norm(k.reshape(B, S, FOX_HEADS, HEAD_DIM), k_g)
    v = v.reshape(B, S, FOX_HEADS, HEAD_DIM)
    logf = jax.nn.log_sigmoid((f + b_f).astype(jnp.float32))
    attn = fox_attention(q, k, v, logf).reshape(B, S, FOX_WIDTH)
    return jnp.concatenate([conv_out, attn], axis=-1) @ w_out


def nsa_mixer(h, w_in, b_gate, q_g, k_g, cmp_pos, cmp_w1, cmp_w2, rel_table, w_out):
    B, S, _ = h.shape
    G, J, Dh = NSA_GROUPS, NSA_HPG, HEAD_DIM
    f32 = jnp.float32
    splits = list(np.cumsum([NSA_WIDTH] + [NSA_KV] * 6))
    q, kc, vc, ks, vs, kw, vw, gl = jnp.split(h @ w_in, splits, axis=-1)
    q = rms_norm(q.reshape(B, S, G, J, Dh), q_g)
    kc, vc, ks, vs, kw, vw = [a.reshape(B, S, G, Dh) for a in (kc, vc, ks, vs, kw, vw)]
    ks = rms_norm(ks, k_g[1])
    kw = rms_norm(kw, k_g[2])
    gates = jax.nn.sigmoid((gl + b_gate).astype(f32)).reshape(B, S, G, J, 3).astype(h.dtype)
    tpos = jnp.arange(S)
    table = rel_table.reshape(REL_BUCKETS, G, J)
    scale = Dh ** -0.5

    n_cmp = (S - CMP_LEN) // CMP_STRIDE + 1
    starts = jnp.arange(n_cmp) * CMP_STRIDE
    ends = starts + CMP_LEN - 1
    tok = starts[:, None] + jnp.arange(CMP_LEN)[None, :]

    def compress(a, pos, w1, w2):
        blk = a[:, tok] + pos[:, None, :]
        blk = blk.transpose(0, 1, 3, 2, 4).reshape(B, n_cmp, G, CMP_LEN * Dh)
        return jax.nn.gelu(blk @ w1) @ w2

    Kc = rms_norm(compress(kc, cmp_pos[0], cmp_w1[0], cmp_w2[0]), k_g[0])
    Vc = compress(vc, cmp_pos[1], cmp_w1[1], cmp_w2[1])
    s_c = jnp.einsum('bsgjd,bngd->bgjsn', q, Kc).astype(f32) * scale
    s_c = s_c + table[rel_bucket(tpos[:, None] - ends[None, :])].transpose(2, 3, 0, 1)
    p_c = masked_softmax(s_c, ends[None, :] <= tpos[:, None])
    o_c = jnp.einsum('bgjsn,bngd->bsgjd', p_c.astype(Vc.dtype), Vc)

    n_slc = S // SLC_LEN
    top_n = min(SLC_TOPN, n_slc)
    blk_ids = jnp.arange(n_slc)
    bstart = blk_ids * SLC_LEN
    overlap = ((starts[:, None] < bstart[None, :] + SLC_LEN)
               & (starts[:, None] + CMP_LEN > bstart[None, :])).astype(f32)
    imp = jnp.einsum('bgjsn,nm->bgsm', p_c, overlap)
    cur = tpos // SLC_LEN
    forced = (blk_ids[None, :] == 0) | (blk_ids[None, :] == cur[:, None]) | (blk_ids[None, :] == cur[:, None] - 1)
    imp = jnp.where(forced, FORCE_SCORE, jnp.where(bstart[None, :] <= tpos[:, None], imp, -1.0))
    sel_score, sel_idx = lax.top_k(imp, top_n)
    sel_valid = sel_score >= 0

    Ks = ks.reshape(B, n_slc, SLC_LEN, G, Dh).transpose(0, 3, 1, 2, 4)
    Vs = vs.reshape(B, n_slc, SLC_LEN, G, Dh).transpose(0, 3, 1, 2, 4)
    nq = S // SLC_QCHUNK
    bi = jnp.arange(B)[:, None, None, None]
    gi = jnp.arange(G)[None, :, None, None]

    def slc_chunk(args):
        qi, idx, val, ti = args
        Kg = Ks[bi, gi, idx]
        Vg = Vs[bi, gi, idx]
        kpos = idx[..., None] * SLC_LEN + jnp.arange(SLC_LEN)
        dist = ti[None, None, :, None, None] - kpos
        mask = val[..., None] & (dist >= 0)
        bias = jnp.moveaxis(table[rel_bucket(dist), gi[..., None]], -1, 2)
        s = jnp.einsum('bqgjd,bgqnld->bgjqnl', qi, Kg).astype(f32) * scale + bias
        sh = s.shape
        m = jnp.broadcast_to(mask[:, :, None], sh).reshape(sh[:4] + (-1,))
        p = masked_softmax(s.reshape(sh[:4] + (-1,)), m).reshape(sh)
        return jnp.einsum('bgjqnl,bgqnld->bqgjd', p.astype(Vg.dtype), Vg)

    qs = q.reshape(B, nq, SLC_QCHUNK, G, J, Dh).swapaxes(0, 1)
    idx_s = sel_idx.reshape(B, G, nq, SLC_QCHUNK, top_n).transpose(2, 0, 1, 3, 4)
    val_s = sel_valid.reshape(B, G, nq, SLC_QCHUNK, top_n).transpose(2, 0, 1, 3, 4)
    t_s = tpos.reshape(nq, SLC_QCHUNK)
    o_s = lax.map(slc_chunk, (qs, idx_s, val_s, t_s)).swapaxes(0, 1).reshape(B, S, G, J, Dh)

    kwp = jnp.pad(kw, ((0, 0), (WINDOW, 0), (0, 0), (0, 0)))
    vwp = jnp.pad(vw, ((0, 0), (WINDOW, 0), (0, 0), (0, 0)))
    nb = S // Q_BLOCK
    span = Q_BLOCK + WINDOW
    koff = jnp.arange(span)
    dist_w = jnp.arange(Q_BLOCK)[:, None] + WINDOW - koff[None, :]
    band = (dist_w >= 0) & (dist_w < WINDOW)
    bias_w = table[rel_bucket(dist_w)].transpose(2, 3, 0, 1)

    def win_block(args):
        qi, i = args
        start = i * Q_BLOCK
        kb = lax.dynamic_slice_in_dim(kwp, start, span, axis=1)
        vb = lax.dynamic_slice_in_dim(vwp, start, span, axis=1)
        s = jnp.einsum('bqgjd,bkgd->bgjqk', qi, kb).astype(f32) * scale + bias_w
        mask = band & ((start - WINDOW + koff) >= 0)[None, :]
        p = masked_softmax(s, mask)
        return jnp.einsum('bgjqk,bkgd->bqgjd', p.astype(vb.dtype), vb)

    qw = q.reshape(B, nb, Q_BLOCK, G, J, Dh).swapaxes(0, 1)
    o_w = lax.map(win_block, (qw, jnp.arange(nb))).swapaxes(0, 1).reshape(B, S, G, J, Dh)

    o = gates[..., 0:1] * o_c + gates[..., 1:2] * o_s + gates[..., 2:3] * o_w
    return o.reshape(B, S, NSA_WIDTH) @ w_out


def peer_ffn(h, w_q, sub_keys, u, v):
    B, S, D = h.shape
    T = B * S
    half = PEER_QDIM // 2
    hc = h.reshape(T // PEER_CHUNK, PEER_CHUNK, D)

    def chunk(xc):
        q = (xc @ w_q).reshape(-1, PEER_HEADS, 2, half)
        s = jnp.einsum('thpd,pkd->thpk', q, sub_keys).astype(jnp.float32)
        sv, si = lax.top_k(s, PEER_TOPK)
        cand = (sv[:, :, 0, :, None] + sv[:, :, 1, None, :]).reshape(-1, PEER_HEADS, PEER_TOPK * PEER_TOPK)
        cand_id = (si[:, :, 0, :, None] * PEER_NKEYS + si[:, :, 1, None, :]).reshape(-1, PEER_HEADS, PEER_TOPK * PEER_TOPK)
        cv, ci = lax.top_k(cand, PEER_TOPK)
        eid = jnp.take_along_axis(cand_id, ci, axis=-1)
        g = jax.nn.softmax(cv, axis=-1)
        ue = u[eid]
        ve = v[eid]
        a = jax.nn.gelu(jnp.einsum('td,thkd->thk', xc, ue)).astype(jnp.float32)
        return jnp.einsum('thk,thkd->td', (g * a).astype(ve.dtype), ve)

    return lax.map(chunk, hc).reshape(B, S, D)


def setup_inputs(seed: int = 0) -> dict:
    key = jax.random.key(seed)
    ks = jax.random.split(key, 24)
    D = D_MODEL

    def nrm(k, shape, s):
        return jax.random.normal(k, shape, jnp.float32) * s

    return {
        'x': nrm(ks[0], (BATCH, SEQ, D), 1.0),
        'c': nrm(ks[1], (BATCH, D), 1.0),
        'ada_w': nrm(ks[2], (DEPTH, D, 6 * D), 0.5 * D ** -0.5),
        'ada_b': nrm(ks[3], (DEPTH, 6 * D), 0.01),
        'norm_g': 1.0 + nrm(ks[4], (DEPTH, 2, D), 0.05),
        'even_w_in': nrm(ks[5], (N_EVEN, D, EVEN_IN), D ** -0.5),
        'even_b_f': jax.random.uniform(ks[6], (N_EVEN, FOX_HEADS), jnp.float32, 1.0, 6.0),
        'even_conv_w': nrm(ks[7], (N_EVEN, CONV_K, CONV_CH), CONV_K ** -0.5),
        'even_q_g': 1.0 + nrm(ks[8], (N_EVEN, HEAD_DIM), 0.05),
        'even_k_g': 1.0 + nrm(ks[9], (N_EVEN, HEAD_DIM), 0.05),
        'even_w_out': nrm(ks[10], (N_EVEN, CONV_CH + FOX_WIDTH, D), (CONV_CH + FOX_WIDTH) ** -0.5),
        'odd_w_in': nrm(ks[11], (N_ODD, D, ODD_IN), D ** -0.5),
        'odd_b_gate': nrm(ks[12], (N_ODD, 3 * NSA_HEADS), 0.01),
        'odd_q_g': 1.0 + nrm(ks[13], (N_ODD, HEAD_DIM), 0.05),
        'odd_k_g': 1.0 + nrm(ks[14], (N_ODD, 3, HEAD_DIM), 0.05),
        'odd_cmp_pos': nrm(ks[15], (N_ODD, 2, CMP_LEN, HEAD_DIM), 0.1),
        'odd_cmp_w1': nrm(ks[16], (N_ODD, 2, CMP_LEN * HEAD_DIM, HEAD_DIM), (CMP_LEN * HEAD_DIM) ** -0.5),
        'odd_cmp_w2': nrm(ks[17], (N_ODD, 2, HEAD_DIM, HEAD_DIM), HEAD_DIM ** -0.5),
        'odd_w_out': nrm(ks[18], (N_ODD, NSA_WIDTH, D), NSA_WIDTH ** -0.5),
        'rel_table': nrm(ks[19], (REL_BUCKETS, NSA_HEADS), 0.5),
        'peer_w_q': nrm(ks[20], (DEPTH, D, PEER_HEADS * PEER_QDIM), D ** -0.5),
        'peer_keys': nrm(ks[21], (DEPTH, 2, PEER_NKEYS, PEER_QDIM // 2), (PEER_QDIM // 2) ** -0.5),
        'peer_u': nrm(ks[22], (DEPTH, PEER_EXPERTS, D), D ** -0.5),
        'peer_v': nrm(ks[23], (DEPTH, PEER_EXPERTS, D), PEER_HEADS ** -0.5),
    }


def reference(x, c, ada_w, ada_b, norm_g, even_w_in, even_b_f, even_conv_w, even_q_g, even_k_g,
              even_w_out, odd_w_in, odd_b_gate, odd_q_g, odd_k_g, odd_cmp_pos, odd_cmp_w1, odd_cmp_w2,
              odd_w_out, rel_table, peer_w_q, peer_keys, peer_u, peer_v):
    mods = jnp.einsum('bd,lde->lbe', jax.nn.silu(c), ada_w) + ada_b[:, None, :]
    for layer in range(DEPTH):
        sh1, sc1, g1, sh2, sc2, g2 = jnp.split(mods[layer], 6, axis=-1)
        h = modulate(rms_norm(x, norm_g[layer, 0]), sh1, sc1)
        i = layer // 2
        if layer % 2 == 0:
            y = conv_fox_mixer(h, even_w_in[i], even_b_f[i], even_conv_w[i], even_q_g[i], even_k_g[i],
                               even_w_out[i])
        else:
            y = nsa_mixer(h, odd_w_in[i], odd_b_gate[i], odd_q_g[i], odd_k_g[i], odd_cmp_pos[i],
                          odd_cmp_w1[i], odd_cmp_w2[i], rel_table, odd_w_out[i])
        x = x + g1[:, None, :] * y
        h = modulate(rms_norm(x, norm_g[layer, 1]), sh2, sc2)
        x = x + g2[:, None, :] * peer_ffn(h, peer_w_q[layer], peer_keys[layer], peer_u[layer], peer_v[layer])
    return x
```

```cpp
#include <hip/hip_runtime.h>
#include <stdint.h>
#include <stdio.h>

#ifndef MK_MULTI
#define MK_MULTI 1
#endif

typedef unsigned short bf16_t;
typedef short bf16x8 __attribute__((ext_vector_type(8)));
typedef float f32x16 __attribute__((ext_vector_type(16)));
typedef float f32x4 __attribute__((ext_vector_type(4)));
typedef float f32x2 __attribute__((ext_vector_type(2)));
typedef unsigned u32x4 __attribute__((ext_vector_type(4)));
typedef unsigned u32x2 __attribute__((ext_vector_type(2)));
typedef __bf16 bf2_t __attribute__((ext_vector_type(2)));

constexpr int T_ = 16384, D_ = 1024, B_ = 8, S_ = 2048;
constexpr int NTHR = 512, NWV = 8;
constexpr int EVEN_N = 3080, EVEN_NP = 3136, EVEN_LD = 3072;
constexpr int ODD_N = 2608, ODD_NP = 2624, ODD_LD = 2560;
constexpr int LDS_BYTES = 98304;

struct P {
    const float *x, *c, *ada_w, *ada_b, *norm_g, *e_w_in, *e_b_f, *e_conv_w, *e_q_g, *e_k_g, *e_w_out;
    const float *o_w_in, *o_b_gate, *o_q_g, *o_k_g, *o_cmp_pos, *o_cmp_w1, *o_cmp_w2, *o_w_out, *rel_table;
    const float *p_w_q, *p_keys, *p_u, *p_v;
    float* out;
    unsigned* bar; float* mods; float* c1;
    bf16_t *winE, *woutE, *winO, *woutO, *wq, *w1t, *w2t, *u16, *v16;
    bf16_t *h, *proj, *cat, *vT, *kc, *vcT;
    float *fg, *cum, *gates, *qp, *selg; int* seli;
};

__device__ __forceinline__ unsigned cvt_pk_bf16(float lo, float hi) { const f32x2 v = {lo, hi}; const bf2_t b = __builtin_convertvector(v, bf2_t); return __builtin_bit_cast(unsigned, b); }
__device__ __forceinline__ float bf_lo(unsigned w) { return __uint_as_float(w << 16); }
__device__ __forceinline__ float bf_hi(unsigned w) { return __uint_as_float(w & 0xffff0000u); }
__device__ __forceinline__ float bf_to_f(bf16_t v) { return __uint_as_float(((unsigned)v) << 16); }
__device__ __forceinline__ bf16_t f_to_bf(float v) { const __bf16 b = (__bf16)v; return __builtin_bit_cast(bf16_t, b); }
__device__ __forceinline__ float rdlane(float v, int l) { return __int_as_float(__builtin_amdgcn_readlane(__float_as_int(v), l)); }
__device__ __forceinline__ int rdlanei(int v, int l) { return __builtin_amdgcn_readlane(v, l); }

#define DPPF(old, src, ctrl, rm) __int_as_float(__builtin_amdgcn_update_dpp(__float_as_int(old), __float_as_int(src), ctrl, rm, 0xf, false))
__device__ __forceinline__ float wave_max(float v) {
    v = fmaxf(v, DPPF(v, v, 0xB1, 0xf)); v = fmaxf(v, DPPF(v, v, 0x4E, 0xf)); v = fmaxf(v, DPPF(v, v, 0x141, 0xf)); v = fmaxf(v, DPPF(v, v, 0x140, 0xf));
    v = fmaxf(v, DPPF(-INFINITY, v, 0x142, 0xa)); v = fmaxf(v, DPPF(-INFINITY, v, 0x143, 0xc));
    return rdlane(v, 63);
}
__device__ __forceinline__ float wave_sum(float v) {
    v += DPPF(v, v, 0xB1, 0xf); v += DPPF(v, v, 0x4E, 0xf); v += DPPF(v, v, 0x141, 0xf); v += DPPF(v, v, 0x140, 0xf);
    v += DPPF(0.f, v, 0x142, 0xa); v += DPPF(0.f, v, 0x143, 0xc);
    return rdlane(v, 63);
}
__device__ __forceinline__ float row16_sum(float v) {
    v += DPPF(v, v, 0xB1, 0xf); v += DPPF(v, v, 0x4E, 0xf); v += DPPF(v, v, 0x141, 0xf); v += DPPF(v, v, 0x140, 0xf); return v;
}
__device__ __forceinline__ float oct_sum(float v) {
    v += DPPF(v, v, 0xB1, 0xf); v += DPPF(v, v, 0x4E, 0xf); v += DPPF(v, v, 0x141, 0xf); return v;
}
__device__ __forceinline__ float gelu_tanh(float x) {
    const float y = 0.7978845608028654f * (x + 0.044715f * x * x * x);
    return x / (1.0f + __expf(-2.0f * y));
}
__device__ __forceinline__ f32x16 mfma32(bf16x8 a, bf16x8 b, f32x16 c) { return __builtin_amdgcn_mfma_f32_32x32x16_bf16(a, b, c, 0, 0, 0); }
__device__ __forceinline__ int rowmap(int rho, int h) { return (rho & 3) + 8 * (rho >> 2) + 4 * h; }
__device__ __forceinline__ int koffs(int i, int h) { return (i & 7) + 8 * h + 16 * (i >> 3); }
__device__ __forceinline__ int swap23(int r) { return (r & 3) | (((r >> 3) & 1) << 2) | (((r >> 2) & 1) << 3) | (r & 16); }
__device__ __forceinline__ bf16x8 ld8(const bf16_t* p) { return *(const bf16x8*)p; }

template <bool SWAP>
__device__ __forceinline__ void gemm_core(const bf16_t* A, const bf16_t* Bt, int K, int m0, int n0, f32x16 (&acc)[2][2]) {
    const int lane = threadIdx.x & 63, r = lane & 31, h = lane >> 5;
    const bf16_t* pa = A + (size_t)(m0 + r) * K + 8 * h;
    const bf16_t* pb = Bt + (size_t)(n0 + r) * K + 8 * h;
    const size_t s32 = (size_t)32 * K;
#pragma unroll
    for (int i = 0; i < 2; ++i)
#pragma unroll
        for (int j = 0; j < 2; ++j)
#pragma unroll
            for (int q = 0; q < 16; ++q) acc[i][j][q] = 0.f;
    bf16x8 a0[2][4], b0[2][4], a1[2][4], b1[2][4];
#define GLOAD(a, b, kk) _Pragma("unroll") for (int i = 0; i < 2; ++i) _Pragma("unroll") for (int ks = 0; ks < 4; ++ks) { a[i][ks] = ld8(pa + i * s32 + (kk) + 16 * ks); b[i][ks] = ld8(pb + i * s32 + (kk) + 16 * ks); }
#define GMMA(a, b) _Pragma("unroll") for (int ks = 0; ks < 4; ++ks) _Pragma("unroll") for (int i = 0; i < 2; ++i) _Pragma("unroll") for (int j = 0; j < 2; ++j) \
        acc[i][j] = SWAP ? mfma32(b[j][ks], a[i][ks], acc[i][j]) : mfma32(a[i][ks], b[j][ks], acc[i][j]);
    GLOAD(a0, b0, 0);
    for (int k0 = 0; k0 < K; k0 += 128) {
        GLOAD(a1, b1, k0 + 64);
        GMMA(a0, b0);
        if (k0 + 128 < K) { GLOAD(a0, b0, k0 + 128); }
        GMMA(a1, b1);
    }
#undef GLOAD
#undef GMMA
}

template <int MODE>
__device__ void phase_gemm(const P& p, int layer) {
    const int lane = threadIdx.x & 63, wid = threadIdx.x >> 6, r = lane & 31, h = lane >> 5;
    const int li = layer >> 1;
    const bf16_t* A; const bf16_t* Bt; int NP;
    if (MODE == 0) { A = p.h; Bt = p.winE + (size_t)li * EVEN_NP * D_; NP = EVEN_NP; }
    else if (MODE == 1) { A = p.h; Bt = p.winO + (size_t)li * ODD_NP * D_; NP = ODD_NP; }
    else if (MODE == 2) { A = p.cat; Bt = ((layer & 1) ? p.woutO : p.woutE) + (size_t)li * D_ * D_; NP = D_; }
    else { A = p.h; Bt = p.wq + (size_t)layer * D_ * D_; NP = D_; }
    const int nTn = NP / 64, ntiles = (T_ / 64) * nTn;
    const int nw = gridDim.x * NWV;
    for (int tile = blockIdx.x * NWV + wid; tile < ntiles; tile += nw) {
        const int tm = tile / nTn, tn = tile - tm * nTn, m0 = tm * 64, n0 = tn * 64;
        bool swp = false;
        if (MODE == 0) swp = (tn >= 40 && tn < 48);
        if (MODE == 1) swp = (tn >= 28 && tn < 32) || (tn >= 36 && tn < 40);
        f32x16 acc[2][2];
        if (swp) {
            gemm_core<true>(A, Bt, D_, m0, n0, acc);
            int vb, nh; bf16_t* dst;
            if (MODE == 0) { vb = 2560; nh = 8; dst = p.vT; } else if (tn < 32) { vb = 1792; nh = 4; dst = p.vT; } else { vb = 2304; nh = 4; dst = p.vT + (size_t)B_ * 4 * 64 * S_; }
#pragma unroll
            for (int i = 0; i < 2; ++i) {
                const int m = m0 + 32 * i + r, b = m >> 11, s = m & 2047;
#pragma unroll
                for (int j = 0; j < 2; ++j)
#pragma unroll
                    for (int q = 0; q < 16; ++q) {
                        const int n = n0 + 32 * j + rowmap(q, h) - vb; const int hd = n >> 6, d = n & 63;
                        dst[((size_t)(b * nh + hd) * 64 + d) * S_ + s] = f_to_bf(acc[i][j][q]);
                    }
            }
        } else {
            gemm_core<false>(A, Bt, D_, m0, n0, acc);
#pragma unroll
            for (int i = 0; i < 2; ++i)
#pragma unroll
                for (int j = 0; j < 2; ++j)
#pragma unroll
                    for (int q = 0; q < 16; ++q) {
                        const int m = m0 + 32 * i + rowmap(q, h), n = n0 + 32 * j + r; const float v = acc[i][j][q];
                        if (MODE == 0) {
                            if (n < EVEN_LD) p.proj[(size_t)m * EVEN_LD + n] = f_to_bf(v);
                            else if (n < EVEN_N) p.fg[(size_t)m * 8 + (n - EVEN_LD)] = v;
                        } else if (MODE == 1) {
                            if (n < ODD_LD) p.proj[(size_t)m * ODD_LD + n] = f_to_bf(v);
                            else if (n < ODD_N) p.fg[(size_t)m * 48 + (n - ODD_LD)] = v;
                        } else if (MODE == 2) {
                            const float* xo = (layer == 0) ? p.x : p.out;
                            const float g1 = p.mods[((size_t)layer * B_ + (m >> 11)) * 6144 + 2048 + n];
                            p.out[(size_t)m * D_ + n] = xo[(size_t)m * D_ + n] + g1 * v;
                        } else {
                            p.qp[(size_t)m * D_ + n] = v;
                        }
                    }
        }
    }
}

__device__ void convT(const float* src, int K, int N, int NP, bf16_t* dst, float* lt) {
    const int tid = threadIdx.x, tk = K / 64, tnn = NP / 64;
    for (int tile = blockIdx.x; tile < tk * tnn; tile += gridDim.x) {
        const int k0 = (tile % tk) * 64, n0 = (tile / tk) * 64;
#pragma unroll
        for (int i = 0; i < 8; ++i) { const int idx = tid + NTHR * i, kk = idx >> 6, nn = idx & 63; lt[nn * 65 + kk] = (n0 + nn < N) ? src[(size_t)(k0 + kk) * N + n0 + nn] : 0.f; }
        __syncthreads();
#pragma unroll
        for (int i = 0; i < 4; ++i) { const int idx = tid + NTHR * i, nn = idx >> 5, kp = (idx & 31) * 2;
            *(unsigned*)(dst + (size_t)(n0 + nn) * K + k0 + kp) = cvt_pk_bf16(lt[nn * 65 + kp], lt[nn * 65 + kp + 1]); }
        __syncthreads();
    }
}
__device__ void conv_plain(const float* src, bf16_t* dst, size_t n) {
    const size_t nth = (size_t)gridDim.x * NTHR;
    for (size_t i = (size_t)blockIdx.x * NTHR + threadIdx.x; i < n / 8; i += nth) {
        const f32x4 a = *(const f32x4*)(src + i * 8), b = *(const f32x4*)(src + i * 8 + 4);
        u32x4 w; w.x = cvt_pk_bf16(a[0], a[1]); w.y = cvt_pk_bf16(a[2], a[3]); w.z = cvt_pk_bf16(b[0], b[1]); w.w = cvt_pk_bf16(b[2], b[3]);
        *(u32x4*)(dst + i * 8) = w;
    }
}
__device__ void phase_prologue(const P& p, char* lds) {
    float* lt = (float*)lds;
    const int tid = threadIdx.x;
    for (int i = 0; i < 2; ++i) {
        convT(p.e_w_in + (size_t)i * D_ * EVEN_N, D_, EVEN_N, EVEN_NP, p.winE + (size_t)i * EVEN_NP * D_, lt);
        convT(p.e_w_out + (size_t)i * D_ * D_, D_, D_, D_, p.woutE + (size_t)i * D_ * D_, lt);
        convT(p.o_w_in + (size_t)i * D_ * ODD_N, D_, ODD_N, ODD_NP, p.winO + (size_t)i * ODD_NP * D_, lt);
        convT(p.o_w_out + (size_t)i * D_ * D_, D_, D_, D_, p.woutO + (size_t)i * D_ * D_, lt);
        for (int kv = 0; kv < 2; ++kv) {
            convT(p.o_cmp_w1 + (size_t)(i * 2 + kv) * 2048 * 64, 2048, 64, 64, p.w1t + (size_t)(i * 2 + kv) * 64 * 2048, lt);
            convT(p.o_cmp_w2 + (size_t)(i * 2 + kv) * 64 * 64, 64, 64, 64, p.w2t + (size_t)(i * 2 + kv) * 64 * 64, lt);
        }
    }
    for (int l = 0; l < 4; ++l) convT(p.p_w_q + (size_t)l * D_ * D_, D_, D_, D_, p.wq + (size_t)l * D_ * D_, lt);
    conv_plain(p.p_u, p.u16, (size_t)4 * 16384 * D_);
    conv_plain(p.p_v, p.v16, (size_t)4 * 16384 * D_);
    for (int u = blockIdx.x; u < 4; u += gridDim.x) {
        const int cc = tid & 63, ch = tid >> 6; float s = 0.f;
        const float* pos = p.o_cmp_pos + (size_t)u * 2048; const float* w1 = p.o_cmp_w1 + (size_t)u * 2048 * 64;
        for (int k = ch * 256; k < ch * 256 + 256; ++k) s += pos[k] * w1[(size_t)k * 64 + cc];
        __syncthreads(); lt[tid] = s; __syncthreads();
        if (tid < 64) { float t = 0.f; for (int q = 0; q < 8; ++q) t += lt[q * 64 + tid]; p.c1[u * 64 + tid] = t; }
        __syncthreads();
    }
    __syncthreads();
    for (int i = tid; i < 8 * D_; i += NTHR) { const float cv = p.c[i]; lt[i] = cv / (1.f + __expf(-cv)); }
    float* part = lt + 8 * D_;
    __syncthreads();
    for (int u = blockIdx.x; u < 4 * 48; u += gridDim.x) {
        const int l = u / 48, ec = u % 48, col = tid & 127, dq = tid >> 7, e = ec * 128 + col;
        float acc[8];
#pragma unroll
        for (int b = 0; b < 8; ++b) acc[b] = 0.f;
        const float* w = p.ada_w + ((size_t)l * D_ + dq * 256) * 6144 + e;
        for (int d = 0; d < 256; ++d) { const float wv = w[(size_t)d * 6144];
#pragma unroll
            for (int b = 0; b < 8; ++b) acc[b] += lt[b * D_ + dq * 256 + d] * wv; }
#pragma unroll
        for (int b = 0; b < 8; ++b) part[(dq * 8 + b) * 128 + col] = acc[b];
        __syncthreads();
        for (int i = tid; i < 8 * 128; i += NTHR) { const int b = i >> 7, cc = i & 127;
            const float s = ((part[(0 * 8 + b) * 128 + cc] + part[(1 * 8 + b) * 128 + cc]) + part[(2 * 8 + b) * 128 + cc]) + part[(3 * 8 + b) * 128 + cc];
            p.mods[((size_t)l * B_ + b) * 6144 + ec * 128 + cc] = s + p.ada_b[l * 6144 + ec * 128 + cc]; }
        __syncthreads();
    }
}

__device__ void phase_norm(const P& p, int layer, int which) {
    const int lane = threadIdx.x & 63, wid = threadIdx.x >> 6;
    const float* xin = (layer == 0 && which == 0) ? p.x : p.out;
    const float* gain = p.norm_g + (size_t)(layer * 2 + which) * D_;
    for (int t = blockIdx.x * NWV + wid; t < T_; t += gridDim.x * NWV) {
        const int b = t >> 11;
        const float* md = p.mods + ((size_t)layer * B_ + b) * 6144 + which * 3072;
        f32x4 v[4]; float ss = 0.f;
#pragma unroll
        for (int i = 0; i < 4; ++i) { v[i] = *(const f32x4*)(xin + (size_t)t * D_ + 4 * lane + 256 * i); ss += v[i][0] * v[i][0] + v[i][1] * v[i][1] + v[i][2] * v[i][2] + v[i][3] * v[i][3]; }
        ss = wave_sum(ss);
        const float rs = rsqrtf(ss * (1.f / D_) + 1e-6f);
#pragma unroll
        for (int i = 0; i < 4; ++i) {
            const int e = 4 * lane + 256 * i;
            const f32x4 g = *(const f32x4*)(gain + e), sh = *(const f32x4*)(md + e), sc = *(const f32x4*)(md + 1024 + e);
            float y[4];
#pragma unroll
            for (int q = 0; q < 4; ++q) y[q] = v[i][q] * rs * g[q] * (1.f + sc[q]) + sh[q];
            u32x2 w; w.x = cvt_pk_bf16(y[0], y[1]); w.y = cvt_pk_bf16(y[2], y[3]);
            *(u32x2*)(p.h + (size_t)t * D_ + e) = w;
        }
    }
}

__device__ __forceinline__ void unpack8(u32x4 w, float (&f)[8]) { f[0] = bf_lo(w.x); f[1] = bf_hi(w.x); f[2] = bf_lo(w.y); f[3] = bf_hi(w.y); f[4] = bf_lo(w.z); f[5] = bf_hi(w.z); f[6] = bf_lo(w.w); f[7] = bf_hi(w.w); }
__device__ __forceinline__ u32x4 pack8(const float (&f)[8]) { u32x4 w; w.x = cvt_pk_bf16(f[0], f[1]); w.y = cvt_pk_bf16(f[2], f[3]); w.z = cvt_pk_bf16(f[4], f[5]); w.w = cvt_pk_bf16(f[6], f[7]); return w; }
__device__ __forceinline__ void headnorm8(bf16_t* ptr, const float* gain8) {
    float f[8]; unpack8(*(const u32x4*)ptr, f);
    float ss = 0.f;
#pragma unroll
    for (int q = 0; q < 8; ++q) ss += f[q] * f[q];
    ss = oct_sum(ss);
    const float rs = rsqrtf(ss * (1.f / 64.f) + 1e-6f);
#pragma unroll
    for (int q = 0; q < 8; ++q) f[q] = f[q] * rs * gain8[q];
    *(u32x4*)ptr = pack8(f);
}
__device__ void phase_post_even(const P& p, int layer) {
    const int lane = threadIdx.x & 63, wid = threadIdx.x >> 6, li = layer >> 1;
    const float* cw = p.e_conv_w + (size_t)li * 3 * 512;
    const int c0 = 8 * lane;
    float w0[8], w1[8], w2[8], qg[8], kg[8];
#pragma unroll
    for (int q = 0; q < 8; ++q) { w0[q] = cw[c0 + q]; w1[q] = cw[512 + c0 + q]; w2[q] = cw[1024 + c0 + q]; qg[q] = p.e_q_g[li * 64 + ((c0 + q) & 63)]; kg[q] = p.e_k_g[li * 64 + ((c0 + q) & 63)]; }
    const int gw = blockIdx.x * NWV + wid, nw = gridDim.x * NWV;
    for (int t = gw; t < T_; t += nw) {
        const int s = t & 2047;
        bf16_t* row = p.proj + (size_t)t * EVEN_LD;
        float cb[8], a[8], b[8], u0[8], u1[8], u2[8];
        unpack8(*(const u32x4*)(row + c0), cb);
        unpack8(*(const u32x4*)(row + 512 + c0), a); unpack8(*(const u32x4*)(row + 1024 + c0), b);
#pragma unroll
        for (int q = 0; q < 8; ++q) u0[q] = a[q] * b[q];
        if (s >= 1) { unpack8(*(const u32x4*)(row - EVEN_LD + 512 + c0), a); unpack8(*(const u32x4*)(row - EVEN_LD + 1024 + c0), b);
#pragma unroll
            for (int q = 0; q < 8; ++q) u1[q] = a[q] * b[q]; }
        else {
#pragma unroll
            for (int q = 0; q < 8; ++q) u1[q] = 0.f; }
        if (s >= 2) { unpack8(*(const u32x4*)(row - 2 * EVEN_LD + 512 + c0), a); unpack8(*(const u32x4*)(row - 2 * EVEN_LD + 1024 + c0), b);
#pragma unroll
            for (int q = 0; q < 8; ++q) u2[q] = a[q] * b[q]; }
        else {
#pragma unroll
            for (int q = 0; q < 8; ++q) u2[q] = 0.f; }
        float o[8];
#pragma unroll
        for (int q = 0; q < 8; ++q) o[q] = cb[q] * (w0[q] * u2[q] + w1[q] * u1[q] + w2[q] * u0[q]);
        *(u32x4*)(p.cat + (size_t)t * D_ + c0) = pack8(o);
        headnorm8(row + 1536 + c0, qg);
        headnorm8(row + 2048 + c0, kg);
    }
    for (int sq = gw; sq < 64; sq += nw) {
        const int b = sq >> 3, hd = sq & 7; const float bf = p.e_b_f[li * 8 + hd];
        float v[32]; float run = 0.f;
#pragma unroll
        for (int i = 0; i < 32; ++i) {
            const float z = p.fg[((size_t)b * S_ + lane * 32 + i) * 8 + hd] + bf;
            const float ls = fminf(z, 0.f) - log1pf(expf(-fabsf(z)));
            run += ls; v[i] = run;
        }
        float incl = run;
#pragma unroll
        for (int d = 1; d < 64; d <<= 1) { const float o = __shfl_up(incl, d); if (lane >= d) incl += o; }
        const float excl = incl - run;
#pragma unroll
        for (int i = 0; i < 32; ++i) p.cum[(size_t)sq * S_ + lane * 32 + i] = v[i] + excl;
    }
}

struct AttnAcc { f32x16 o[2]; float m, l; };
__device__ __forceinline__ void attn_init(AttnAcc& a) {
#pragma unroll
    for (int q = 0; q < 16; ++q) { a.o[0][q] = 0.f; a.o[1][q] = 0.f; }
    a.m = -INFINITY; a.l = 0.f;
}
__device__ __forceinline__ f32x16 attn_scores(const bf16_t* kbase, int ldk, const bf16x8 (&qf)[4]) {
    const int lane = threadIdx.x & 63, r = lane & 31, h = lane >> 5;
    const bf16_t* kp = kbase + (size_t)swap23(r) * ldk + 8 * h;
    bf16x8 kf[4];
#pragma unroll
    for (int ks = 0; ks < 4; ++ks) kf[ks] = ld8(kp + 16 * ks);
    f32x16 s;
#pragma unroll
    for (int q = 0; q < 16; ++q) s[q] = 0.f;
#pragma unroll
    for (int ks = 0; ks < 4; ++ks) s = mfma32(kf[ks], qf[ks], s);
    return s;
}
__device__ __forceinline__ void attn_update(AttnAcc& a, const f32x16& s, const bf16_t* vt, int ldv) {
    const int lane = threadIdx.x & 63, r = lane & 31, h = lane >> 5;
    bf16x8 vf[2][2];
#pragma unroll
    for (int db = 0; db < 2; ++db)
#pragma unroll
        for (int ks = 0; ks < 2; ++ks) vf[db][ks] = ld8(vt + (size_t)(32 * db + r) * ldv + 16 * ks + 8 * h);
    float mx = s[0];
#pragma unroll
    for (int q = 1; q < 16; ++q) mx = fmaxf(mx, s[q]);
    mx = fmaxf(mx, __shfl_xor(mx, 32));
    const float mn = fmaxf(a.m, mx), ms = (mn == -INFINITY) ? 0.f : mn;
    const float alpha = __expf(a.m - ms);
    float pv[16], ps = 0.f;
#pragma unroll
    for (int q = 0; q < 16; ++q) { pv[q] = __expf(s[q] - ms); ps += pv[q]; }
    a.l = a.l * alpha + ps; a.m = mn;
#pragma unroll
    for (int q = 0; q < 16; ++q) { a.o[0][q] *= alpha; a.o[1][q] *= alpha; }
    union { bf16x8 v; unsigned u[4]; } pf[2];
#pragma unroll
    for (int ks = 0; ks < 2; ++ks)
#pragma unroll
        for (int q = 0; q < 4; ++q) pf[ks].u[q] = cvt_pk_bf16(pv[8 * ks + 2 * q], pv[8 * ks + 2 * q + 1]);
#pragma unroll
    for (int db = 0; db < 2; ++db)
#pragma unroll
        for (int ks = 0; ks < 2; ++ks) a.o[db] = mfma32(vf[db][ks], pf[ks].v, a.o[db]);
}

__device__ void phase_fox(const P& p, int layer) {
    const int lane = threadIdx.x & 63, wid = threadIdx.x >> 6, r = lane & 31, h = lane >> 5;
    const int nw = gridDim.x * NWV;
    for (int u = blockIdx.x * NWV + wid; u < 2048; u += nw) {
        const int b = u >> 8, hd = (u >> 5) & 7, ii = u & 31;
        const float* cumrow = p.cum + (size_t)(b * 8 + hd) * S_;
        const bf16_t* kb = p.proj + (size_t)b * S_ * EVEN_LD + 2048 + hd * 64;
        const bf16_t* vtb = p.vT + (size_t)(b * 8 + hd) * 64 * S_;
        for (int half = 0; half < 2; ++half) {
            const int qt = half ? (63 - ii) : ii, q0 = qt * 32, tq = q0 + r;
            const size_t t = (size_t)b * S_ + tq;
            bf16x8 qf[4];
#pragma unroll
            for (int ks = 0; ks < 4; ++ks) qf[ks] = ld8(p.proj + t * EVEN_LD + 1536 + hd * 64 + 16 * ks + 8 * h);
            const float ct = cumrow[tq];
            AttnAcc a; attn_init(a);
            for (int k0 = 0; k0 <= q0; k0 += 32) {
                f32x16 s = attn_scores(kb + (size_t)k0 * EVEN_LD, EVEN_LD, qf);
                const f32x4 c0 = *(const f32x4*)(cumrow + k0 + 8 * h), c1 = *(const f32x4*)(cumrow + k0 + 8 * h + 4);
                const f32x4 c2 = *(const f32x4*)(cumrow + k0 + 16 + 8 * h), c3 = *(const f32x4*)(cumrow + k0 + 16 + 8 * h + 4);
                float ck[16] = {c0[0], c0[1], c0[2], c0[3], c1[0], c1[1], c1[2], c1[3], c2[0], c2[1], c2[2], c2[3], c3[0], c3[1], c3[2], c3[3]};
#pragma unroll
                for (int q = 0; q < 16; ++q) { const int key = k0 + koffs(q, h); s[q] = (key <= tq) ? (s[q] * 0.125f + (ct - ck[q])) : -INFINITY; }
                attn_update(a, s, vtb + k0, S_);
            }
            const float lt = a.l + __shfl_xor(a.l, 32), inv = 1.f / lt;
            bf16_t* dst = p.cat + t * D_ + 512 + hd * 64;
#pragma unroll
            for (int db = 0; db < 2; ++db)
#pragma unroll
                for (int g4 = 0; g4 < 4; ++g4) {
                    u32x2 w; w.x = cvt_pk_bf16(a.o[db][4 * g4] * inv, a.o[db][4 * g4 + 1] * inv); w.y = cvt_pk_bf16(a.o[db][4 * g4 + 2] * inv, a.o[db][4 * g4 + 3] * inv);
                    *(u32x2*)(dst + 32 * db + 8 * g4 + 4 * h) = w;
                }
        }
    }
}

__device__ void phase_post_odd(const P& p, int layer) {
    const int lane = threadIdx.x & 63, wid = threadIdx.x >> 6, li = layer >> 1, r = lane & 31, h = lane >> 5;
    const int c0 = 8 * lane;
    float qg[8], k1[8], k2[8];
#pragma unroll
    for (int q = 0; q < 8; ++q) { qg[q] = p.o_q_g[li * 64 + ((c0 + q) & 63)]; k1[q] = p.o_k_g[(li * 3 + 1) * 64 + ((c0 + q) & 63)]; k2[q] = p.o_k_g[(li * 3 + 2) * 64 + ((c0 + q) & 63)]; }
    const int gw = blockIdx.x * NWV + wid, nw = gridDim.x * NWV;
    for (int t = gw; t < T_; t += nw) {
        bf16_t* row = p.proj + (size_t)t * ODD_LD;
        headnorm8(row + c0, qg); headnorm8(row + 512 + c0, qg);
        { float kg[8];
#pragma unroll
          for (int q = 0; q < 8; ++q) kg[q] = (lane < 32) ? k1[q] : k2[q];
          headnorm8((lane < 32) ? (row + 1536 + c0) : (row + 2048 + (c0 - 256)), kg); }
        if (lane < 48) { const float z = p.fg[(size_t)t * 48 + lane] + p.o_b_gate[li * 48 + lane]; p.gates[(size_t)t * 48 + lane] = 1.f / (1.f + __expf(-z)); }
    }
    for (int u = gw; u < 256; u += nw) {
        const int kv = u >> 7, b = (u >> 4) & 7, g = (u >> 2) & 3, nt = u & 3;
        const int n = nt * 32 + r;
        const bf16_t* w1t = p.w1t + (size_t)(li * 2 + kv) * 64 * 2048;
        const bf16_t* w2t = p.w2t + (size_t)(li * 2 + kv) * 64 * 64;
        const float* c1 = p.c1 + (li * 2 + kv) * 64;
        const int colb = 1024 + kv * 256 + g * 64;
        f32x16 hacc[2];
#pragma unroll
        for (int q = 0; q < 16; ++q) { hacc[0][q] = 0.f; hacc[1][q] = 0.f; }
        for (int l = 0; l < 32; ++l) {
            int tok = 16 * n + l; if (tok > 2047) tok = 2047;
            const bf16_t* ar = p.proj + ((size_t)b * S_ + tok) * ODD_LD + colb + 8 * h;
#pragma unroll
            for (int ks = 0; ks < 4; ++ks) {
                const bf16x8 bfrag = ld8(ar + 16 * ks);
#pragma unroll
                for (int ct = 0; ct < 2; ++ct) {
                    const bf16x8 afrag = ld8(w1t + (size_t)(32 * ct + swap23(r)) * 2048 + l * 64 + 16 * ks + 8 * h);
                    hacc[ct] = mfma32(afrag, bfrag, hacc[ct]);
                }
            }
        }
        union { bf16x8 v; unsigned uu[4]; } hf[2][2];
#pragma unroll
        for (int ct = 0; ct < 2; ++ct)
#pragma unroll
            for (int ks = 0; ks < 2; ++ks)
#pragma unroll
                for (int q = 0; q < 4; ++q) {
                    const int i0 = 8 * ks + 2 * q, cA = 32 * ct + koffs(i0, h), cB = 32 * ct + koffs(i0 + 1, h);
                    hf[ct][ks].uu[q] = cvt_pk_bf16(gelu_tanh(hacc[ct][i0] + c1[cA]), gelu_tanh(hacc[ct][i0 + 1] + c1[cB]));
                }
        f32x16 oacc[2];
#pragma unroll
        for (int q = 0; q < 16; ++q) { oacc[0][q] = 0.f; oacc[1][q] = 0.f; }
#pragma unroll
        for (int et = 0; et < 2; ++et)
#pragma unroll
            for (int ct = 0; ct < 2; ++ct)
#pragma unroll
                for (int ks = 0; ks < 2; ++ks) {
                    const bf16x8 afrag = ld8(w2t + (size_t)(32 * et + r) * 64 + 32 * ct + 16 * ks + 8 * h);
                    oacc[et] = mfma32(afrag, hf[ct][ks].v, oacc[et]);
                }
        if (kv == 0) {
            float ss = 0.f;
#pragma unroll
            for (int q = 0; q < 16; ++q) ss += oacc[0][q] * oacc[0][q] + oacc[1][q] * oacc[1][q];
            ss += __shfl_xor(ss, 32);
            const float rs = rsqrtf(ss * (1.f / 64.f) + 1e-6f);
            bf16_t* dst = p.kc + ((size_t)(b * 4 + g) * 128 + n) * 64;
            const float* kg = p.o_k_g + (size_t)(li * 3) * 64;
#pragma unroll
            for (int et = 0; et < 2; ++et)
#pragma unroll
                for (int g4 = 0; g4 < 4; ++g4) {
                    const int e = 32 * et + 8 * g4 + 4 * h;
                    u32x2 w; w.x = cvt_pk_bf16(oacc[et][4 * g4] * rs * kg[e], oacc[et][4 * g4 + 1] * rs * kg[e + 1]); w.y = cvt_pk_bf16(oacc[et][4 * g4 + 2] * rs * kg[e + 2], oacc[et][4 * g4 + 3] * rs * kg[e + 3]);
                    *(u32x2*)(dst + e) = w;
                }
        } else {
            bf16_t* dst = p.vcT + (size_t)(b * 4 + g) * 64 * 128;
#pragma unroll
            for (int et = 0; et < 2; ++et)
#pragma unroll
                for (int q = 0; q < 16; ++q) dst[(size_t)(32 * et + rowmap(q, h)) * 128 + n] = f_to_bf(oacc[et][q]);
        }
    }
}

__device__ __forceinline__ int rel_bucket_dev(int n) {
    if (n < 16) return n;
    const int thr[15] = {19, 21, 24, 27, 31, 35, 40, 46, 52, 59, 67, 77, 87, 99, 113};
    int bk = 16;
#pragma unroll
    for (int k = 0; k < 15; ++k) bk += (n >= thr[k]) ? 1 : 0;
    return bk;
}
__device__ void phase_nsa(const P& p, int layer, char* lds) {
    const int tid = threadIdx.x, lane = tid & 63, wid = tid >> 6, r = lane & 31, h = lane >> 5;
    float* lut = (float*)lds;
    float* GS = (float*)(lds + 2048);
    float* myG = GS + wid * 2 * 32 * 33; float* myL = myG + 32 * 33;
    const int j = wid & 3, usel = wid >> 2;
    for (int bu = blockIdx.x; bu < 1024; bu += gridDim.x) {
        const int rnd = bu / 256, k = bu % 256, bg = k >> 3, i8 = k & 7;
        const int pp = (rnd == 0) ? i8 : (rnd == 1) ? (15 - i8) : (rnd == 2) ? (16 + i8) : (31 - i8);
        const int b = bg >> 2, g = bg & 3;
        __syncthreads();
        { const int jj = tid >> 7, dist = tid & 127; lut[tid] = p.rel_table[rel_bucket_dev(dist) * 16 + g * 4 + jj]; }
        __syncthreads();
        const float* mylut = lut + j * 128; const float b31 = mylut[127];
        const int qt = 2 * pp + usel, q0 = qt * 32, tq = q0 + r;
        const size_t t = (size_t)b * S_ + tq;
        const int head = g * 4 + j;
        bf16x8 qf[4];
#pragma unroll
        for (int ks = 0; ks < 4; ++ks) qf[ks] = ld8(p.proj + t * ODD_LD + head * 64 + 16 * ks + 8 * h);
        const bf16_t* kcb = p.kc + (size_t)(b * 4 + g) * 128 * 64;
        const bf16_t* vcb = p.vcT + (size_t)(b * 4 + g) * 64 * 128;
        float mx = -INFINITY, lsum = 0.f;
        const int nkt = (q0 >> 9) + 1;
        auto cmp_scores = [&](int kt) {
            f32x16 s = attn_scores(kcb + (size_t)kt * 32 * 64, 64, qf);
#pragma unroll
            for (int q = 0; q < 16; ++q) {
                const int n = 32 * kt + koffs(q, h), dist = tq - (16 * n + 31);
                const float bias = (dist >= 0 && dist < 128) ? mylut[dist] : b31;
                s[q] = (dist >= 0 && n < 127) ? (s[q] * 0.125f + bias) : -INFINITY;
            }
            return s;
        };
        for (int kt = 0; kt < nkt; ++kt) {
            const f32x16 s = cmp_scores(kt);
            float tm = s[0];
#pragma unroll
            for (int q = 1; q < 16; ++q) tm = fmaxf(tm, s[q]);
            tm = fmaxf(tm, __shfl_xor(tm, 32));
            const float mn = fmaxf(mx, tm), ms = (mn == -INFINITY) ? 0.f : mn;
            float ps = 0.f;
#pragma unroll
            for (int q = 0; q < 16; ++q) ps += __expf(s[q] - ms);
            lsum = lsum * __expf(mx - ms) + ps; mx = mn;
        }
        lsum += __shfl_xor(lsum, 32);
        const float msafe = (mx == -INFINITY) ? 0.f : mx;
        const float linv = (lsum > 0.f) ? 1.f / lsum : 0.f;
        f32x16 oc[2];
#pragma unroll
        for (int q = 0; q < 16; ++q) { oc[0][q] = 0.f; oc[1][q] = 0.f; }
#pragma unroll
        for (int m = 0; m < 32; ++m) { if ((m >> 1 & 1) == h) { myG[r * 33 + m] = 0.f; myL[r * 33 + m] = 0.f; } }
        for (int kt = 0; kt < nkt; ++kt) {
            f32x16 s = cmp_scores(kt);
#pragma unroll
            for (int q = 0; q < 16; ++q) s[q] = __expf(s[q] - msafe) * linv;
#pragma unroll
            for (int gq = 0; gq < 4; ++gq) {
                const int m = 8 * kt + 2 * h + (gq & 1) + 4 * (gq >> 1);
                myG[r * 33 + m] = s[4 * gq] + s[4 * gq + 1] + s[4 * gq + 2] + s[4 * gq + 3];
                myL[r * 33 + m] = s[4 * gq + 3];
            }
            union { bf16x8 v; unsigned uu[4]; } pf[2];
#pragma unroll
            for (int ks = 0; ks < 2; ++ks)
#pragma unroll
                for (int q = 0; q < 4; ++q) pf[ks].uu[q] = cvt_pk_bf16(s[8 * ks + 2 * q], s[8 * ks + 2 * q + 1]);
#pragma unroll
            for (int db = 0; db < 2; ++db)
#pragma unroll
                for (int ks = 0; ks < 2; ++ks) oc[db] = mfma32(ld8(vcb + (size_t)(32 * db + r) * 128 + 32 * kt + 16 * ks + 8 * h), pf[ks].v, oc[db]);
        }
        __syncthreads();
        unsigned selmask;
        {
            const float* G0 = GS + (usel * 4) * 2 * 32 * 33;
            float imp[32];
            const int cur = tq >> 6;
#pragma unroll
            for (int m = 0; m < 32; ++m) {
                float v = 0.f;
#pragma unroll
                for (int jj = 0; jj < 4; ++jj) { const float* Gj = G0 + jj * 2 * 32 * 33; v += Gj[r * 33 + m]; if (m > 0) v += Gj[32 * 33 + r * 33 + m - 1]; }
                imp[m] = (m == 0 || m == cur || m == cur - 1) ? 1e6f : ((m <= cur) ? v : -1.f);
            }
            unsigned mym = 0;
#pragma unroll
            for (int mi = 0; mi < 16; ++mi) {
                const unsigned hm = (unsigned)(-h); const int myidx = 16 * h + mi;
                const float mine = __uint_as_float((__float_as_uint(imp[mi]) & ~hm) | (__float_as_uint(imp[16 + mi]) & hm));
                int rank = 0;
#pragma unroll
                for (int m2 = 0; m2 < 32; ++m2) rank += (imp[m2] > mine || (imp[m2] == mine && m2 < myidx)) ? 1 : 0;
                if (rank < 16 && myidx <= cur) mym |= (1u << myidx);
            }
            selmask = mym | (unsigned)__shfl_xor((int)mym, 32);
        }
        const bf16_t* ksb = p.proj + (size_t)b * S_ * ODD_LD + 1536 + g * 64;
        const bf16_t* vsb = p.vT + (size_t)(b * 4 + g) * 64 * S_;
        AttnAcc as; attn_init(as);
        for (int k0 = 0; k0 <= q0; k0 += 32) {
            const int mb = k0 >> 6;
            if (__ballot((selmask >> mb) & 1u) == 0ull) continue;
            f32x16 s = attn_scores(ksb + (size_t)k0 * ODD_LD, ODD_LD, qf);
            const bool on = (selmask >> mb) & 1u;
#pragma unroll
            for (int q = 0; q < 16; ++q) {
                const int dist = tq - (k0 + koffs(q, h));
                const float bias = (dist >= 0 && dist < 128) ? mylut[dist] : b31;
                s[q] = (on && dist >= 0) ? (s[q] * 0.125f + bias) : -INFINITY;
            }
            attn_update(as, s, vsb + k0, S_);
        }
        const bf16_t* kwb = p.proj + (size_t)b * S_ * ODD_LD + 2048 + g * 64;
        const bf16_t* vwb = p.vT + (size_t)B_ * 4 * 64 * S_ + (size_t)(b * 4 + g) * 64 * S_;
        AttnAcc aw; attn_init(aw);
        for (int k0 = (q0 >= 512 ? q0 - 512 : 0); k0 <= q0; k0 += 32) {
            f32x16 s = attn_scores(kwb + (size_t)k0 * ODD_LD, ODD_LD, qf);
#pragma unroll
            for (int q = 0; q < 16; ++q) {
                const int dist = tq - (k0 + koffs(q, h));
                const float bias = (dist >= 0 && dist < 128) ? mylut[dist] : b31;
                s[q] = (dist >= 0 && dist < 512) ? (s[q] * 0.125f + bias) : -INFINITY;
            }
            attn_update(aw, s, vwb + k0, S_);
        }
        const float* gt = p.gates + t * 48 + (g * 4 + j) * 3;
        const float gc = gt[0];
        const float ls = as.l + __shfl_xor(as.l, 32), lw = aw.l + __shfl_xor(aw.l, 32);
        const float gs = gt[1] / ls, gwv = gt[2] / lw;
        bf16_t* dst = p.cat + t * D_ + head * 64;
#pragma unroll
        for (int db = 0; db < 2; ++db)
#pragma unroll
            for (int g4 = 0; g4 < 4; ++g4) {
                float o[4];
#pragma unroll
                for (int q = 0; q < 4; ++q) o[q] = gc * oc[db][4 * g4 + q] + gs * as.o[db][4 * g4 + q] + gwv * aw.o[db][4 * g4 + q];
                u32x2 w; w.x = cvt_pk_bf16(o[0], o[1]); w.y = cvt_pk_bf16(o[2], o[3]);
                *(u32x2*)(dst + 32 * db + 8 * g4 + 4 * h) = w;
            }
    }
}

__device__ void phase_peer_sel(const P& p, int layer, char* lds) {
    const int tid = threadIdx.x, lane = tid & 63, wid = tid >> 6;
    float* keysT = (float*)lds;
    const float* ksrc = p.p_keys + (size_t)layer * 2 * 128 * 64;
    __syncthreads();
    for (int idx = tid; idx < 2 * 128 * 64; idx += NTHR) { const int pp = idx >> 13, key = (idx >> 6) & 127, d = idx & 63; keysT[(pp * 64 + d) * 128 + key] = ksrc[idx]; }
    __syncthreads();
    int ci, cj;
    { const int L = lane; int st;
      if (L < 16) { ci = 0; st = 0; } else if (L < 24) { ci = 1; st = 16; } else if (L < 29) { ci = 2; st = 24; } else if (L < 33) { ci = 3; st = 29; } else if (L < 36) { ci = 4; st = 33; }
      else if (L < 38) { ci = 5; st = 36; } else if (L < 40) { ci = 6; st = 38; } else if (L < 42) { ci = 7; st = 40; } else { ci = 8 + (L - 42); st = L; }
      cj = L - st; if (L >= 50) { ci = 0; cj = 0; } }
    const int nw = gridDim.x * NWV;
    for (int pr = blockIdx.x * NWV + wid; pr < T_ * 8; pr += nw) {
        const int t = pr >> 3, hd = pr & 7;
        const float* q = p.qp + (size_t)t * D_ + hd * 128;
        const float qa = q[lane], qb = q[64 + lane];
        float s00 = 0.f, s01 = 0.f, s10 = 0.f, s11 = 0.f;
#pragma unroll 8
        for (int d = 0; d < 64; ++d) {
            const float a = rdlane(qa, d), bq = rdlane(qb, d);
            s00 += a * keysT[d * 128 + lane]; s01 += a * keysT[d * 128 + 64 + lane];
            s10 += bq * keysT[(64 + d) * 128 + lane]; s11 += bq * keysT[(64 + d) * 128 + 64 + lane];
        }
        float sv[2]; int si[2];
#pragma unroll
        for (int pp = 0; pp < 2; ++pp) {
            float v0 = pp ? s10 : s00, v1 = pp ? s11 : s01; float mv = -INFINITY; int mi = 0;
            for (int it = 0; it < 16; ++it) {
                const float M = wave_max(fmaxf(v0, v1));
                const unsigned long long b0 = __ballot(v0 == M);
                int idx;
                if (b0) { idx = __builtin_ctzll(b0); if (lane == idx) v0 = -INFINITY; }
                else { const unsigned long long b1 = __ballot(v1 == M); idx = __builtin_ctzll(b1); if (lane == idx) v1 = -INFINITY; idx += 64; }
                if (lane == it) { mv = M; mi = idx; }
            }
            sv[pp] = mv; si[pp] = mi;
        }
        float cand = __shfl(sv[0], ci) + __shfl(sv[1], cj);
        const int cid = __shfl(si[0], ci) * 128 + __shfl(si[1], cj);
        if (lane >= 50) cand = -INFINITY;
        float cv = -INFINITY; int ce = 0;
        for (int it = 0; it < 16; ++it) {
            const float M = wave_max(cand);
            const unsigned long long b0 = __ballot(cand == M);
            const int idx = __builtin_ctzll(b0);
            const int e = rdlanei(cid, idx);
            if (lane == idx) cand = -INFINITY;
            if (lane == it) { cv = M; ce = e; }
        }
        const float top = rdlane(cv, 0);
        const float ex = (lane < 16) ? __expf(cv - top) : 0.f;
        const float den = wave_sum(ex);
        if (lane < 16) { p.seli[(size_t)pr * 16 + lane] = ce; p.selg[(size_t)pr * 16 + lane] = ex / den; }
    }
}

__device__ void phase_peer_main(const P& p, int layer) {
    const int lane = threadIdx.x & 63, wid = threadIdx.x >> 6;
    const int nw = gridDim.x * NWV;
    const bf16_t* U = p.u16 + (size_t)layer * 16384 * D_; const bf16_t* V = p.v16 + (size_t)layer * 16384 * D_;
    for (int t = blockIdx.x * NWV + wid; t < T_; t += nw) {
        const int b = t >> 11;
        const u32x4 h0 = *(const u32x4*)(p.h + (size_t)t * D_ + 8 * lane), h1 = *(const u32x4*)(p.h + (size_t)t * D_ + 512 + 8 * lane);
        const unsigned hw[8] = {h0.x, h0.y, h0.z, h0.w, h1.x, h1.y, h1.z, h1.w};
        const int e0 = p.seli[(size_t)t * 128 + lane], e1 = p.seli[(size_t)t * 128 + 64 + lane];
        const float g0 = p.selg[(size_t)t * 128 + lane], g1 = p.selg[(size_t)t * 128 + 64 + lane];
        float acc[16];
#pragma unroll
        for (int q = 0; q < 16; ++q) acc[q] = 0.f;
        for (int bt = 0; bt < 16; ++bt) {
            u32x4 ua[8], ub[8], va[8], vb[8]; float gg[8];
#pragma unroll
            for (int e = 0; e < 8; ++e) {
                const int idx = bt * 8 + e;
                const int eid = (idx < 64) ? rdlanei(e0, idx & 63) : rdlanei(e1, idx & 63);
                gg[e] = (idx < 64) ? rdlane(g0, idx & 63) : rdlane(g1, idx & 63);
                const bf16_t* ur = U + (size_t)eid * D_ + 8 * lane; const bf16_t* vr = V + (size_t)eid * D_ + 8 * lane;
                ua[e] = *(const u32x4*)ur; ub[e] = *(const u32x4*)(ur + 512); va[e] = *(const u32x4*)vr; vb[e] = *(const u32x4*)(vr + 512);
            }
#pragma unroll
            for (int e = 0; e < 8; ++e) {
                const unsigned uw[8] = {ua[e].x, ua[e].y, ua[e].z, ua[e].w, ub[e].x, ub[e].y, ub[e].z, ub[e].w};
                float d = 0.f;
#pragma unroll
                for (int q = 0; q < 8; ++q) d = __builtin_amdgcn_fdot2_f32_bf16(__builtin_bit_cast(bf2_t, uw[q]), __builtin_bit_cast(bf2_t, hw[q]), d, false);
                d = wave_sum(d);
                const float w = gg[e] * gelu_tanh(d);
                const unsigned vw[8] = {va[e].x, va[e].y, va[e].z, va[e].w, vb[e].x, vb[e].y, vb[e].z, vb[e].w};
#pragma unroll
                for (int q = 0; q < 8; ++q) { acc[2 * q] += w * bf_lo(vw[q]); acc[2 * q + 1] += w * bf_hi(vw[q]); }
            }
        }
        const float* g2 = p.mods + ((size_t)layer * B_ + b) * 6144 + 5120;
        float* xr = p.out + (size_t)t * D_;
#pragma unroll
        for (int half = 0; half < 2; ++half)
#pragma unroll
            for (int q4 = 0; q4 < 2; ++q4) {
                const int e = 512 * half + 8 * lane + 4 * q4;
                f32x4 xv = *(const f32x4*)(xr + e); const f32x4 gv = *(const f32x4*)(g2 + e);
#pragma unroll
                for (int q = 0; q < 4; ++q) xv[q] += gv[q] * acc[8 * half + 4 * q4 + q];
                *(f32x4*)(xr + e) = xv;
            }
    }
}

enum { PH_PRO = 0, PH_NORM1, PH_GIN_E, PH_POST_E, PH_FOX, PH_GIN_O, PH_POST_O, PH_NSA, PH_GOUT, PH_NORM2, PH_GQ, PH_SEL, PH_PEER };

template <int PH>
__device__ __forceinline__ void run_phase(const P& p, int layer, char* lds) {
    if (PH == PH_PRO) phase_prologue(p, lds);
    else if (PH == PH_NORM1) phase_norm(p, layer, 0);
    else if (PH == PH_GIN_E) phase_gemm<0>(p, layer);
    else if (PH == PH_POST_E) phase_post_even(p, layer);
    else if (PH == PH_FOX) phase_fox(p, layer);
    else if (PH == PH_GIN_O) phase_gemm<1>(p, layer);
    else if (PH == PH_POST_O) phase_post_odd(p, layer);
    else if (PH == PH_NSA) phase_nsa(p, layer, lds);
    else if (PH == PH_GOUT) phase_gemm<2>(p, layer);
    else if (PH == PH_NORM2) phase_norm(p, layer, 1);
    else if (PH == PH_GQ) phase_gemm<3>(p, layer);
    else if (PH == PH_SEL) phase_peer_sel(p, layer, lds);
    else if (PH == PH_PEER) phase_peer_main(p, layer);
}

template <int PH>
__global__ void __launch_bounds__(NTHR, 2) k_phase(P p, int layer) {
    __shared__ __attribute__((aligned(16))) char lds[(PH == PH_PRO || PH == PH_NSA || PH == PH_SEL) ? LDS_BYTES : 16];
    run_phase<PH>(p, layer, lds);
}

#ifdef DBG_CHECK
__global__ void k_check(const void* buf, int isbf, size_t rows, int ld, int c0, int nc, int stage, unsigned* flag) {
    bool bad = false;
    const size_t n = rows * (size_t)nc;
    for (size_t i = (size_t)blockIdx.x * blockDim.x + threadIdx.x; i < n; i += (size_t)gridDim.x * blockDim.x) {
        const size_t r = i / nc; const int c = (int)(i - r * nc) + c0;
        float v = isbf ? __uint_as_float(((unsigned)((const bf16_t*)buf)[r * ld + c]) << 16) : ((const float*)buf)[r * ld + c];
        if (!(fabsf(v) < 1e30f)) bad = true;
    }
    if (bad) atomicMax(flag, (unsigned)(1000 - stage));
}
__global__ void k_report(float* o, size_t n, const unsigned* flag) {
    const unsigned f = *flag; const float v = f ? ldexpf(1.f, 1000 - (int)f) : 0.5f;
    for (size_t i = (size_t)blockIdx.x * blockDim.x + threadIdx.x; i < n; i += (size_t)gridDim.x * blockDim.x) o[i] = v;
}
#endif
static inline size_t al256(size_t x) { return (x + 255) & ~(size_t)255; }

extern "C" void kernel_launch(void* const* d_in, const int* in_sizes, int n_in, void* d_out, int out_size, void* d_ws, size_t ws_size, hipStream_t stream) {
    P p{};
    const float** f = (const float**)d_in;
    p.x = f[0]; p.c = f[1]; p.ada_w = f[2]; p.ada_b = f[3]; p.norm_g = f[4]; p.e_w_in = f[5]; p.e_b_f = f[6]; p.e_conv_w = f[7]; p.e_q_g = f[8]; p.e_k_g = f[9]; p.e_w_out = f[10];
    p.o_w_in = f[11]; p.o_b_gate = f[12]; p.o_q_g = f[13]; p.o_k_g = f[14]; p.o_cmp_pos = f[15]; p.o_cmp_w1 = f[16]; p.o_cmp_w2 = f[17]; p.o_w_out = f[18]; p.rel_table = f[19];
    p.p_w_q = f[20]; p.p_keys = f[21]; p.p_u = f[22]; p.p_v = f[23];
    p.out = (float*)d_out;
    char* w = (char*)d_ws; size_t off = 0;
    auto take = [&](size_t bytes) { char* r = w + off; off += al256(bytes); return r; };
    p.bar = (unsigned*)take(16384);
    p.mods = (float*)take((size_t)4 * 8 * 6144 * 4);
    const size_t zero_bytes = off;
    p.c1 = (float*)take(4 * 64 * 4);
    p.winE = (bf16_t*)take((size_t)2 * EVEN_NP * D_ * 2); p.woutE = (bf16_t*)take((size_t)2 * D_ * D_ * 2);
    p.winO = (bf16_t*)take((size_t)2 * ODD_NP * D_ * 2); p.woutO = (bf16_t*)take((size_t)2 * D_ * D_ * 2);
    p.wq = (bf16_t*)take((size_t)4 * D_ * D_ * 2); p.w1t = (bf16_t*)take((size_t)4 * 64 * 2048 * 2); p.w2t = (bf16_t*)take((size_t)4 * 64 * 64 * 2);
    p.u16 = (bf16_t*)take((size_t)4 * 16384 * D_ * 2); p.v16 = (bf16_t*)take((size_t)4 * 16384 * D_ * 2);
    p.h = (bf16_t*)take((size_t)T_ * D_ * 2); p.proj = (bf16_t*)take((size_t)T_ * EVEN_LD * 2); p.cat = (bf16_t*)take((size_t)T_ * D_ * 2);
    p.vT = (bf16_t*)take((size_t)T_ * 512 * 2); p.kc = (bf16_t*)take((size_t)B_ * 4 * 128 * 64 * 2); p.vcT = (bf16_t*)take((size_t)B_ * 4 * 64 * 128 * 2);
    p.fg = (float*)take((size_t)T_ * 48 * 4); p.cum = (float*)take((size_t)64 * S_ * 4); p.gates = (float*)take((size_t)T_ * 48 * 4);
    p.qp = (float*)take((size_t)T_ * D_ * 4); p.selg = (float*)take((size_t)T_ * 128 * 4); p.seli = (int*)take((size_t)T_ * 128 * 4);
    if (off > ws_size) { fprintf(stderr, "kernel_launch: workspace too small (%zu > %zu)\n", off, ws_size); return; }
    (void)hipMemsetAsync(d_ws, 0, zero_bytes, stream);
    const int grid = 256;
#define LAUNCH(PH, layer) hipLaunchKernelGGL((k_phase<PH>), dim3(grid), dim3(NTHR), 0, stream, p, layer)
#ifdef DBG_CHECK
    unsigned* flag = p.bar + 4000;
#define CHK(buf, isbf, rows, ld, c0, nc, stage) hipLaunchKernelGGL(k_check, dim3(1024), dim3(256), 0, stream, (const void*)(buf), isbf, (size_t)(rows), ld, c0, nc, stage, flag)
#else
#define CHK(buf, isbf, rows, ld, c0, nc, stage)
#endif
    LAUNCH(PH_PRO, 0);
    CHK(p.mods, 0, 32, 6144, 0, 6144, 1); CHK(p.c1, 0, 1, 256, 0, 256, 1);
    CHK(p.winE, 1, 2 * EVEN_NP, D_, 0, D_, 2); CHK(p.woutE, 1, 2 * D_, D_, 0, D_, 2); CHK(p.winO, 1, 2 * ODD_NP, D_, 0, D_, 2); CHK(p.woutO, 1, 2 * D_, D_, 0, D_, 2);
    CHK(p.wq, 1, 4 * D_, D_, 0, D_, 2); CHK(p.w1t, 1, 4 * 64, 2048, 0, 2048, 2); CHK(p.w2t, 1, 4 * 64, 64, 0, 64, 2);
    CHK(p.u16, 1, 4 * 16384, D_, 0, D_, 3); CHK(p.v16, 1, 4 * 16384, D_, 0, D_, 3);
    for (int layer = 0; layer < 4; ++layer) {
        const int sb = 4 + layer * 9;
        LAUNCH(PH_NORM1, layer); CHK(p.h, 1, T_, D_, 0, D_, sb + 0);
        if ((layer & 1) == 0) {
            LAUNCH(PH_GIN_E, layer);
#ifdef DBG_FINE
            CHK(p.proj, 1, T_, EVEN_LD, 0, 512, 5); CHK(p.proj, 1, T_, EVEN_LD, 512, 512, 6); CHK(p.proj, 1, T_, EVEN_LD, 1024, 512, 7); CHK(p.proj, 1, T_, EVEN_LD, 1536, 512, 8); CHK(p.proj, 1, T_, EVEN_LD, 2048, 512, 9);
            CHK(p.vT, 1, T_, 512, 0, 512, 10); CHK(p.fg, 0, T_, 8, 0, 8, 11);
            hipLaunchKernelGGL(k_report, dim3(1024), dim3(256), 0, stream, p.out, (size_t)T_ * D_, (const unsigned*)flag);
            return;
#endif
            CHK(p.proj, 1, T_, EVEN_LD, 0, 2560, sb + 1); CHK(p.vT, 1, T_, 512, 0, 512, sb + 1); CHK(p.fg, 0, T_, 8, 0, 8, sb + 1);
            LAUNCH(PH_POST_E, layer); CHK(p.proj, 1, T_, EVEN_LD, 0, 2560, sb + 2); CHK(p.cat, 1, T_, D_, 0, 512, sb + 2); CHK(p.cum, 0, 64, S_, 0, S_, sb + 2);
            LAUNCH(PH_FOX, layer); CHK(p.cat, 1, T_, D_, 0, D_, sb + 3);
        } else {
            LAUNCH(PH_GIN_O, layer); CHK(p.proj, 1, T_, ODD_LD, 0, 1792, sb + 1); CHK(p.proj, 1, T_, ODD_LD, 2048, 256, sb + 1); CHK(p.vT, 1, T_, 512, 0, 512, sb + 1); CHK(p.fg, 0, T_, 48, 0, 48, sb + 1);
            LAUNCH(PH_POST_O, layer); CHK(p.proj, 1, T_, ODD_LD, 0, 1792, sb + 2); CHK(p.proj, 1, T_, ODD_LD, 2048, 256, sb + 2); CHK(p.gates, 0, T_, 48, 0, 48, sb + 2);
            CHK(p.kc, 1, 32 * 128, 64, 0, 64, sb + 2); CHK(p.vcT, 1, 32 * 64, 128, 0, 128, sb + 2);
            LAUNCH(PH_NSA, layer); CHK(p.cat, 1, T_, D_, 0, D_, sb + 3);
        }
        LAUNCH(PH_GOUT, layer); CHK(p.out, 0, T_, D_, 0, D_, sb + 4);
        LAUNCH(PH_NORM2, layer); CHK(p.h, 1, T_, D_, 0, D_, sb + 5);
        LAUNCH(PH_GQ, layer); CHK(p.qp, 0, T_, D_, 0, D_, sb + 6);
        LAUNCH(PH_SEL, layer); CHK(p.selg, 0, T_, 128, 0, 128, sb + 7);
        LAUNCH(PH_PEER, layer); CHK(p.out, 0, T_, D_, 0, D_, sb + 8);
    }
#ifdef DBG_CHECK
    hipLaunchKernelGGL(k_report, dim3(1024), dim3(256), 0, stream, p.out, (size_t)T_ * D_, (const unsigned*)flag);
#endif
}
```

```cpp
#include <hip/hip_runtime.h>
#include <type_traits>
#include <stdint.h>
#include <stdio.h>

#ifndef MK_SIMPLE_GEMM
#define MK_SIMPLE_GEMM 0
#endif
#ifndef PROBE_GHOST
#define PROBE_GHOST 0
#endif
#ifndef PROBE_REP
#define PROBE_REP 0
#endif
#ifndef MK_MULTI
#define MK_MULTI 0
#endif

typedef unsigned short bf16_t;
typedef short bf16x8 __attribute__((ext_vector_type(8)));
typedef float f32x16 __attribute__((ext_vector_type(16)));
typedef float f32x4 __attribute__((ext_vector_type(4)));
typedef float f32x2 __attribute__((ext_vector_type(2)));
typedef unsigned u32x4 __attribute__((ext_vector_type(4)));
typedef unsigned u32x2 __attribute__((ext_vector_type(2)));
typedef __bf16 bf2_t __attribute__((ext_vector_type(2)));

constexpr int T_ = 16384, D_ = 1024, B_ = 8, S_ = 2048;
constexpr int NTHR = 512, NWV = 8;
constexpr int EVEN_N = 3080, EVEN_NP = 3136, EVEN_LD = 3072;
constexpr int ODD_N = 2608, ODD_NP = 2816, ODD_LD = 2560;
constexpr int LDS_BYTES = 131072;
constexpr float LOG2E = 1.4426950408889634f;

typedef int v8i32 __attribute__((ext_vector_type(8)));
typedef float v16f32 __attribute__((ext_vector_type(16)));
typedef unsigned v6u32 __attribute__((ext_vector_type(6)));
typedef unsigned u32x3 __attribute__((ext_vector_type(3)));
struct P {
    const float *x, *c, *ada_w, *ada_b, *norm_g, *e_w_in, *e_b_f, *e_conv_w, *e_q_g, *e_k_g, *e_w_out;
    const float *o_w_in, *o_b_gate, *o_q_g, *o_k_g, *o_cmp_pos, *o_cmp_w1, *o_cmp_w2, *o_w_out, *rel_table;
    const float *p_w_q, *p_keys, *p_u, *p_v;
    float* out;
    unsigned* bar; float* mods; float* c1;
    bf16_t *winE, *woutE, *winO, *woutO, *wq, *w1t, *w2t, *keys16; unsigned char *u8, *v8;
    bf16_t *h, *proj, *cat, *vT, *kt, *kc, *vcT;
    float *fg, *cum, *gates, *qp, *selg, *wexp; int* seli;
    unsigned char* h8; float *hinv, *winv;
};

__device__ __forceinline__ unsigned cvt_pk_bf16(float lo, float hi) { const f32x2 v = {lo, hi}; const bf2_t b = __builtin_convertvector(v, bf2_t); return __builtin_bit_cast(unsigned, b); }
__device__ __forceinline__ float bf_lo(unsigned w) { return __uint_as_float(w << 16); }
__device__ __forceinline__ float bf_hi(unsigned w) { return __uint_as_float(w & 0xffff0000u); }
__device__ __forceinline__ float bf_to_f(bf16_t v) { return __uint_as_float(((unsigned)v) << 16); }
__device__ __forceinline__ bf16_t f_to_bf(float v) { const __bf16 b = (__bf16)v; return __builtin_bit_cast(bf16_t, b); }
__device__ __forceinline__ float rdlane(float v, int l) { return __int_as_float(__builtin_amdgcn_readlane(__float_as_int(v), l)); }
__device__ __forceinline__ int rdlanei(int v, int l) { return __builtin_amdgcn_readlane(v, l); }

__device__ __forceinline__ int opaque_tid(int wv) { int l; asm volatile("v_mbcnt_lo_u32_b32 %0, -1, 0\n\tv_mbcnt_hi_u32_b32 %0, -1, %0" : "=v"(l)); return wv * 64 + l; }
#define DPPF(old, src, ctrl, rm) __int_as_float(__builtin_amdgcn_update_dpp(__float_as_int(old), __float_as_int(src), ctrl, rm, 0xf, false))
__device__ __forceinline__ float wave_max(float v) {
    v = fmaxf(v, DPPF(v, v, 0xB1, 0xf)); v = fmaxf(v, DPPF(v, v, 0x4E, 0xf)); v = fmaxf(v, DPPF(v, v, 0x141, 0xf)); v = fmaxf(v, DPPF(v, v, 0x140, 0xf));
    v = fmaxf(v, DPPF(-INFINITY, v, 0x142, 0xa)); v = fmaxf(v, DPPF(-INFINITY, v, 0x143, 0xc));
    return rdlane(v, 63);
}
__device__ __forceinline__ float wave_sum(float v) {
    v += DPPF(v, v, 0xB1, 0xf); v += DPPF(v, v, 0x4E, 0xf); v += DPPF(v, v, 0x141, 0xf); v += DPPF(v, v, 0x140, 0xf);
    v += DPPF(0.f, v, 0x142, 0xa); v += DPPF(0.f, v, 0x143, 0xc);
    return rdlane(v, 63);
}
__device__ __forceinline__ unsigned wave_or(unsigned v) {
#define DPPU(old, src, ctrl, rm) ((unsigned)__builtin_amdgcn_update_dpp((int)(old), (int)(src), ctrl, rm, 0xf, false))
    v |= DPPU(v, v, 0xB1, 0xf); v |= DPPU(v, v, 0x4E, 0xf); v |= DPPU(v, v, 0x141, 0xf); v |= DPPU(v, v, 0x140, 0xf);
    v |= DPPU(0u, v, 0x142, 0xa); v |= DPPU(0u, v, 0x143, 0xc);
#undef DPPU
    return (unsigned)__builtin_amdgcn_readlane((int)v, 63);
}
__device__ __forceinline__ float row16_sum(float v) {
    v += DPPF(v, v, 0xB1, 0xf); v += DPPF(v, v, 0x4E, 0xf); v += DPPF(v, v, 0x141, 0xf); v += DPPF(v, v, 0x140, 0xf); return v;
}
__device__ __forceinline__ float oct_sum(float v) {
    v += DPPF(v, v, 0xB1, 0xf); v += DPPF(v, v, 0x4E, 0xf); v += DPPF(v, v, 0x141, 0xf); return v;
}
__device__ __forceinline__ float gelu_tanh(float x) {
    const float y = 0.7978845608028654f * (x + 0.044715f * x * x * x);
    return x / (1.0f + __expf(-2.0f * y));
}
__device__ __forceinline__ f32x16 mfma32(bf16x8 a, bf16x8 b, f32x16 c) { return __builtin_amdgcn_mfma_f32_32x32x16_bf16(a, b, c, 0, 0, 0); }
__device__ __forceinline__ int rowmap(int rho, int h) { return (rho & 3) + 8 * (rho >> 2) + 4 * h; }
__device__ __forceinline__ int koffs(int i, int h) { return (i & 7) + 8 * h + 16 * (i >> 3); }
__device__ __forceinline__ constexpr int kofc(int i) { return (i & 7) + 16 * (i >> 3); }
__device__ __forceinline__ int swap23(int r) { return (r & 3) | (((r >> 3) & 1) << 2) | (((r >> 2) & 1) << 3) | (r & 16); }
__device__ __forceinline__ bf16x8 ld8(const bf16_t* p) { return *(const bf16x8*)p; }
__device__ __forceinline__ size_t ktile_elem(int key, int d) { return (size_t)(key >> 5) * 2048 + (size_t)((((d >> 4) * 2 + ((d >> 3) & 1)) * 32 + swap23(key & 31)) * 8 + (d & 7)); }
__device__ __forceinline__ size_t vtile_elem(int key, int d) { const int kk = key & 31; return (size_t)(key >> 5) * 2048 + (size_t)((((((d >> 5) * 2 + (kk >> 4)) * 2 + ((kk >> 3) & 1)) * 32 + (d & 31)) * 8) + (kk & 7)); }

template <bool SWAP>
__device__ __forceinline__ void gemm_core(const bf16_t* A, const bf16_t* Bt, int K, int m0, int n0, f32x16 (&acc)[2][2], int r, int h) {
    const bf16_t* pa = A + (size_t)(m0 + r) * K + 8 * h;
    const bf16_t* pb = Bt + (size_t)(n0 + r) * K + 8 * h;
    const size_t s32 = (size_t)32 * K;
#pragma unroll
    for (int i = 0; i < 2; ++i)
#pragma unroll
        for (int j = 0; j < 2; ++j)
#pragma unroll
            for (int q = 0; q < 16; ++q) acc[i][j][q] = 0.f;
    bf16x8 a0[2][4], b0[2][4], a1[2][4], b1[2][4];
#define GLOAD(a, b, kk) _Pragma("unroll") for (int i = 0; i < 2; ++i) _Pragma("unroll") for (int ks = 0; ks < 4; ++ks) { a[i][ks] = ld8(pa + i * s32 + (kk) + 16 * ks); b[i][ks] = ld8(pb + i * s32 + (kk) + 16 * ks); }
#define GMMA(a, b) _Pragma("unroll") for (int ks = 0; ks < 4; ++ks) _Pragma("unroll") for (int i = 0; i < 2; ++i) _Pragma("unroll") for (int j = 0; j < 2; ++j) \
        acc[i][j] = SWAP ? mfma32(b[j][ks], a[i][ks], acc[i][j]) : mfma32(a[i][ks], b[j][ks], acc[i][j]);
    GLOAD(a0, b0, 0);
    for (int k0 = 0; k0 < K; k0 += 128) {
        GLOAD(a1, b1, k0 + 64);
        GMMA(a0, b0);
        if (k0 + 128 < K) { GLOAD(a0, b0, k0 + 128); }
        GMMA(a1, b1);
    }
#undef GLOAD
#undef GMMA
}

namespace pg8 {
#define PG8_LAS __attribute__((address_space(3)))
constexpr int BM = 256, BK = 64, HALF = 128, HTB = HALF * BK * 2  , STAGE_BYTES = 8 * HTB, NXCD = 8, WGM = 8;

__host__ __device__ __forceinline__ int lds_byte(int r, int c) { const int st = (r >> 4) * 2 + (c >> 5), rr = r & 15, cc = c & 31, ob = rr * 64 + cc * 2; return st * 1024 + (ob ^ (((ob >> 9) & 1) << 5)); }
__host__ __device__ __forceinline__ void stage_rc(int b, int& R, int& C) { const int st = b / 1024, sb = b % 1024, swz = sb ^ (((sb >> 9) & 1) << 5); R = (st >> 1) * 16 + swz / 64; C = (st & 1) * 32 + (swz % 64) / 2; }
__host__ __device__ __forceinline__ int perm32(int rho) { const int n = rho >> 4, i = rho & 15; return 8 * (i >> 2) + 4 * n + (i & 3); }

struct Unit { int pm, pn; };
struct Gemm { const bf16_t* A; const bf16_t* Bt; int M, N, K; };

struct StaticOrder {
    int nM, nN, nwg, G, c;
    __host__ __device__ void init(int M, int N, int G_, int c_) { nM = M / BM; nN = N / BM; nwg = nM * nN; G = G_; c = c_; }
    __host__ __device__ bool next(int i, Unit& u) const {
        const long L = (long)i * G + c; if (L >= nwg) return false;
        int wgid = (int)L; { const int q = nwg / NXCD, r = nwg % NXCD, xcd = wgid % NXCD, off = wgid / NXCD; wgid = (xcd < r ? xcd * (q + 1) : r * (q + 1) + (xcd - r) * q) + off; }
        const int nig = WGM * nN, gid = wgid / nig, fm = gid * WGM, gsz = (nM - fm) < WGM ? (nM - fm) : WGM;
        u.pm = fm + ((wgid % nig) % gsz); u.pn = (wgid % nig) / gsz; return true;
    }
    __device__ __forceinline__ void a_ready(const Unit&) const {}
    __device__ __forceinline__ void done(const Unit&) const {}
};
template <class Epi, class Sched, bool ALIGN_EPI = false, bool SP2 = false>
__device__ __forceinline__ void gemm_phase(PG8_LAS unsigned char* lds, const Gemm g, const Sched& S, const Epi& E, int wv) {
    const int tid = opaque_tid(wv), wid = __builtin_amdgcn_readfirstlane(tid >> 6), lane = tid & 63, wr = wid >> 2, wc = wid & 3, fr = lane & 15, fq = lane >> 4;
    const int K = g.K, nt = K / BK;
    unsigned voffA[2], voffB[2];
#pragma unroll
    for (int i = 0; i < 2; ++i) { int R, C; stage_rc(tid * 16 + i * 8192, R, C); const int Rb = Epi::PERM ? ((R & ~31) + perm32(R & 31)) : R;
        voffA[i] = (unsigned)(R * K + C) * 2u; voffB[i] = (unsigned)(Rb * K + C) * 2u; }
    const size_t kstep = (size_t)(BK * 2);
    const size_t hstep = (size_t)HALF * K * 2;
    const size_t tstep = 2 * hstep;
    const unsigned ldsw = (unsigned)wid * 1024u;
    const int aoff = lds_byte(wr * 64 + fr, fq * 8), boff = lds_byte(wc * 32 + fr, fq * 8);
#define PG8_SA(b, h) (((b) * 2 + (h)) * HTB)
#define PG8_SB(b, h) ((4 + (b) * 2 + (h)) * HTB)
#define PG8_STAGE(bufoff, gbase, voff) do { _Pragma("unroll") for (int _i = 0; _i < 2; ++_i) \
        __builtin_amdgcn_global_load_lds((const unsigned*)((const char*)(gbase) + (voff)[_i]), (PG8_LAS unsigned*)(lds + (bufoff) + ldsw + _i * 8192), 16, 0, 0); } while (0)
#define PG8_LDA(dst, b, h) do { _Pragma("unroll") for (int m = 0; m < 4; ++m) _Pragma("unroll") for (int k = 0; k < 2; ++k) dst[m][k] = *(const PG8_LAS bf16x8*)(lds + PG8_SA(b, h) + aoff + m * 2048 + k * 1024); } while (0)
#define PG8_LDB(dst, b, h) do { _Pragma("unroll") for (int n = 0; n < 2; ++n) _Pragma("unroll") for (int k = 0; k < 2; ++k) dst[n][k] = *(const PG8_LAS bf16x8*)(lds + PG8_SB(b, h) + boff + n * 2048 + k * 1024); } while (0)
#define PG8_MMA(ai, bj, At, Bt) do { __builtin_amdgcn_s_setprio(1); _Pragma("unroll") for (int m = 0; m < 4; ++m) _Pragma("unroll") for (int n = 0; n < 2; ++n) _Pragma("unroll") for (int k = 0; k < 2; ++k) \
        acc[ai][bj][m][n] = __builtin_amdgcn_mfma_f32_16x16x32_bf16(Bt[n][k], At[m][k], acc[ai][bj][m][n], 0, 0, 0); __builtin_amdgcn_s_setprio(0); } while (0)
#define PG8_WAIT_V(n) asm volatile("s_waitcnt vmcnt(" #n ")" ::: "memory")
#define PG8_WAIT_L(n) asm volatile("s_waitcnt lgkmcnt(" #n ")" ::: "memory")
#define PG8_BAR __builtin_amdgcn_s_barrier()
#define PG8_SCHED __builtin_amdgcn_sched_barrier(0)
    Unit cur, nxt; int ui = 0;
    if (!S.next(0, cur)) return;
    f32x4 acc[2][2][4][2];
#pragma unroll
    for (int a = 0; a < 2; ++a)
#pragma unroll
        for (int b = 0; b < 2; ++b)
#pragma unroll
            for (int m = 0; m < 4; ++m)
#pragma unroll
                for (int n = 0; n < 2; ++n) acc[a][b][m][n] = (f32x4){0.f, 0.f, 0.f, 0.f};
    bf16x8 At[4][2], B0[2][2], B1[2][2];
    const char* cA = (const char*)g.A + (size_t)cur.pm * tstep; const char* cB = (const char*)g.Bt + (size_t)cur.pn * tstep;
    S.a_ready(cur);
    if constexpr (SP2) {
        PG8_STAGE(PG8_SB(0, 0), cB, voffB); PG8_STAGE(PG8_SB(0, 1), cB + hstep, voffB); PG8_STAGE(PG8_SA(0, 0), cA, voffA); PG8_STAGE(PG8_SA(0, 1), cA + hstep, voffA);
        if (wr == 1) PG8_BAR;
        PG8_WAIT_V(2); PG8_BAR;
        PG8_STAGE(PG8_SB(1, 0), cB + kstep, voffB); PG8_STAGE(PG8_SA(1, 0), cA + kstep, voffA); PG8_STAGE(PG8_SB(1, 1), cB + hstep + kstep, voffB);
        PG8_WAIT_V(6); PG8_BAR;
    } else {
        PG8_STAGE(PG8_SB(0, 0), cB, voffB); PG8_STAGE(PG8_SA(0, 0), cA, voffA); PG8_STAGE(PG8_SB(0, 1), cB + hstep, voffB); PG8_STAGE(PG8_SA(0, 1), cA + hstep, voffA);
        if (wr == 1) PG8_BAR;
        PG8_WAIT_V(4); PG8_BAR;
        PG8_STAGE(PG8_SB(1, 0), cB + kstep, voffB); PG8_STAGE(PG8_SA(1, 0), cA + kstep, voffA); PG8_STAGE(PG8_SB(1, 1), cB + hstep + kstep, voffB);
        PG8_WAIT_V(6); PG8_BAR;
    }
    for (;;) {
        const bool has_next = S.next(ui + 1, nxt);
        const char* nA = has_next ? (const char*)g.A + (size_t)nxt.pm * tstep : cA; const char* nB = has_next ? (const char*)g.Bt + (size_t)nxt.pn * tstep : cB;
        for (int t = 0; t < nt; t += 2) {
            const bool last = (t == nt - 2);
            const char* a1 = cA + (size_t)(t + 1) * kstep;
            const char* a2 = last ? nA : cA + (size_t)(t + 2) * kstep; const char* b2 = last ? nB : cB + (size_t)(t + 2) * kstep;
            const char* a3 = a2 + kstep; const char* b3 = b2 + kstep;
            if (last && has_next) S.a_ready(nxt);
            if constexpr (SP2) {
            PG8_LDB(B0, 0, 0); PG8_LDB(B1, 0, 1); PG8_SCHED; PG8_LDA(At, 0, 0); PG8_STAGE(PG8_SA(1, 1), a1 + hstep, voffA);
            PG8_WAIT_V(8); PG8_WAIT_L(0); PG8_BAR; PG8_MMA(0, 0, At, B0); PG8_MMA(0, 1, At, B1); PG8_BAR; PG8_SCHED;
            PG8_LDA(At, 0, 1); PG8_STAGE(PG8_SB(0, 0), b2, voffB); PG8_STAGE(PG8_SB(0, 1), b2 + hstep, voffB); PG8_STAGE(PG8_SA(0, 0), a2, voffA);
            PG8_WAIT_V(8); PG8_WAIT_L(0); PG8_BAR; PG8_MMA(1, 0, At, B0); PG8_MMA(1, 1, At, B1); PG8_BAR; PG8_SCHED;
            PG8_LDB(B0, 1, 0); PG8_LDB(B1, 1, 1); PG8_SCHED; PG8_LDA(At, 1, 0); PG8_STAGE(PG8_SA(0, 1), a2 + hstep, voffA);
            PG8_WAIT_V(8); PG8_WAIT_L(0); PG8_BAR; PG8_MMA(0, 0, At, B0); PG8_MMA(0, 1, At, B1); PG8_BAR; PG8_SCHED;
            PG8_LDA(At, 1, 1); PG8_STAGE(PG8_SB(1, 0), b3, voffB); PG8_STAGE(PG8_SB(1, 1), b3 + hstep, voffB); PG8_STAGE(PG8_SA(1, 0), a3, voffA);
            PG8_WAIT_V(8); PG8_WAIT_L(0); PG8_BAR; PG8_MMA(1, 0, At, B0); PG8_MMA(1, 1, At, B1); PG8_BAR; PG8_SCHED;
            } else {
            PG8_LDB(B0, 0, 0); PG8_SCHED; PG8_LDA(At, 0, 0); PG8_STAGE(PG8_SA(1, 1), a1 + hstep, voffA);
            PG8_WAIT_L(8); PG8_BAR; PG8_WAIT_L(0); PG8_MMA(0, 0, At, B0); PG8_BAR; PG8_SCHED;
            PG8_LDB(B1, 0, 1); PG8_STAGE(PG8_SB(0, 0), b2, voffB);
            PG8_BAR; PG8_WAIT_L(0); PG8_MMA(0, 1, At, B1); PG8_BAR;
            PG8_LDA(At, 0, 1); PG8_STAGE(PG8_SA(0, 0), a2, voffA);
            PG8_BAR; PG8_WAIT_L(0); PG8_MMA(1, 0, At, B0); PG8_BAR; PG8_SCHED;
            PG8_STAGE(PG8_SB(0, 1), b2 + hstep, voffB);
            PG8_WAIT_V(6); PG8_BAR; PG8_MMA(1, 1, At, B1); PG8_BAR;
            PG8_LDB(B0, 1, 0); PG8_SCHED; PG8_LDA(At, 1, 0); PG8_STAGE(PG8_SA(0, 1), a2 + hstep, voffA);
            PG8_WAIT_L(8); PG8_BAR; PG8_WAIT_L(0); PG8_MMA(0, 0, At, B0); PG8_BAR; PG8_SCHED;
            PG8_LDB(B1, 1, 1); PG8_STAGE(PG8_SB(1, 0), b3, voffB);
            PG8_BAR; PG8_WAIT_L(0); PG8_MMA(0, 1, At, B1); PG8_BAR;
            PG8_LDA(At, 1, 1); PG8_STAGE(PG8_SA(1, 0), a3, voffA);
            PG8_BAR; PG8_WAIT_L(0); PG8_MMA(1, 0, At, B0); PG8_BAR; PG8_SCHED;
            PG8_STAGE(PG8_SB(1, 1), b3 + hstep, voffB);
            PG8_WAIT_V(6); PG8_BAR; PG8_MMA(1, 1, At, B1); PG8_BAR;
            }
        }
        if constexpr (ALIGN_EPI) { if (wr == 0) PG8_BAR; }
        if constexpr (!Epi::AFTER_DRAIN) { E(acc, cur, wr, wc, fr, fq); S.done(cur); }
        if (!has_next) break;
#pragma unroll
        for (int a = 0; a < 2; ++a)
#pragma unroll
            for (int b = 0; b < 2; ++b)
#pragma unroll
                for (int m = 0; m < 4; ++m)
#pragma unroll
                    for (int n = 0; n < 2; ++n) acc[a][b][m][n] = (f32x4){0.f, 0.f, 0.f, 0.f};
        cur = nxt; cA = nA; cB = nB; ++ui;
        if constexpr (ALIGN_EPI) { if (wr == 1) PG8_BAR; }
    }
    PG8_WAIT_V(0);
    if constexpr (!ALIGN_EPI) { if (wr == 0) PG8_BAR; }
    PG8_BAR;
    if constexpr (Epi::AFTER_DRAIN) { E.fused(acc, cur, wr, wc, fr, fq, lds, wid, lane); S.done(cur); }
#undef PG8_SA
#undef PG8_SB
#undef PG8_STAGE
#undef PG8_LDA
#undef PG8_LDB
#undef PG8_MMA
#undef PG8_WAIT_V
#undef PG8_WAIT_L
#undef PG8_BAR
#undef PG8_SCHED
}
}

template <int LD, int GT, int GN>
struct EpiIn {
    static constexpr bool PERM = true, AFTER_DRAIN = false;
    bf16_t* proj; float* gl;
    __device__ __forceinline__ void operator()(const f32x4 (&acc)[2][2][4][2], const pg8::Unit& u, int wr, int wc, int fr, int fq) const {
        const int row0 = u.pm * 256 + wr * 64 + fr, col0 = u.pn * 256 + wc * 32 + 8 * fq;
        if (GT < 0 || u.pn != GT) {
#pragma unroll
            for (int ai = 0; ai < 2; ++ai)
#pragma unroll
                for (int m = 0; m < 4; ++m) { bf16_t* rowp = proj + (size_t)(row0 + ai * 128 + m * 16) * LD + col0;
#pragma unroll
                    for (int bj = 0; bj < 2; ++bj) { const f32x4 v0 = acc[ai][bj][m][0], v1 = acc[ai][bj][m][1];
                        u32x4 w; w.x = cvt_pk_bf16(v0[0], v0[1]); w.y = cvt_pk_bf16(v0[2], v0[3]); w.z = cvt_pk_bf16(v1[0], v1[1]); w.w = cvt_pk_bf16(v1[2], v1[3]);
                        *(u32x4*)(rowp + bj * 128) = w; } }
        } else {
            const int c0 = wc * 32 + 8 * fq;
            if (c0 < GN) {
#pragma unroll
                for (int ai = 0; ai < 2; ++ai)
#pragma unroll
                    for (int m = 0; m < 4; ++m) { float* gp = gl + (size_t)(row0 + ai * 128 + m * 16) * GN + c0;
                        *(f32x4*)gp = acc[ai][0][m][0]; *(f32x4*)(gp + 4) = acc[ai][0][m][1]; }
            }
        }
    }
};
struct EpiOut {
    static constexpr bool PERM = false, AFTER_DRAIN = false;
    const float* xold; float* out; const float* g1;
    __device__ __forceinline__ void operator()(const f32x4 (&acc)[2][2][4][2], const pg8::Unit& u, int wr, int wc, int fr, int fq) const {
        const int row0 = u.pm * 256 + wr * 64 + fr, col0 = u.pn * 256 + wc * 32 + 4 * fq;
#pragma unroll
        for (int ai = 0; ai < 2; ++ai)
#pragma unroll
            for (int m = 0; m < 4; ++m) { const int row = row0 + ai * 128 + m * 16; const size_t off = (size_t)row * D_ + col0; const float* gp = g1 + (size_t)(row >> 11) * 6144 + col0;
#pragma unroll
                for (int bj = 0; bj < 2; ++bj)
#pragma unroll
                    for (int n = 0; n < 2; ++n) { const f32x4 xv = *(const f32x4*)(xold + off + bj * 128 + n * 16), gv = *(const f32x4*)(gp + bj * 128 + n * 16);
                        *(f32x4*)(out + off + bj * 128 + n * 16) = xv + gv * acc[ai][bj][m][n]; } }
    }
};
struct EpiF32 {
    static constexpr bool PERM = false, AFTER_DRAIN = false;
    float* out;
    __device__ __forceinline__ void operator()(const f32x4 (&acc)[2][2][4][2], const pg8::Unit& u, int wr, int wc, int fr, int fq) const {
        const int row0 = u.pm * 256 + wr * 64 + fr, col0 = u.pn * 256 + wc * 32 + 4 * fq;
#pragma unroll
        for (int ai = 0; ai < 2; ++ai)
#pragma unroll
            for (int m = 0; m < 4; ++m) { const size_t off = (size_t)(row0 + ai * 128 + m * 16) * D_ + col0;
#pragma unroll
                for (int bj = 0; bj < 2; ++bj)
#pragma unroll
                    for (int n = 0; n < 2; ++n) *(f32x4*)(out + off + bj * 128 + n * 16) = acc[ai][bj][m][n]; }
    }
};

template <int MODE>
__device__ __forceinline__ void phase_gemm_simple(const P& p, int layer, int tn_only, int wv) {
    const int tid = opaque_tid(wv), lane = tid & 63, wid = __builtin_amdgcn_readfirstlane(tid >> 6), r = lane & 31, h = lane >> 5;
    const int li = layer >> 1;
    const bf16_t* A; const bf16_t* Bt; int NP;
    if (MODE == 0) { A = p.h; Bt = p.winE + (size_t)li * EVEN_NP * D_; NP = EVEN_NP; }
    else if (MODE == 1) { A = p.h; Bt = p.winO + (size_t)li * ODD_NP * D_; NP = ODD_NP; }
    else if (MODE == 2) { A = p.cat; Bt = ((layer & 1) ? p.woutO : p.woutE) + (size_t)li * D_ * D_; NP = D_; }
    else { A = p.h; Bt = p.wq + (size_t)layer * D_ * D_; NP = D_; }
    const int nTn = NP / 64, ntiles = (T_ / 64) * nTn;
    const int nw = gridDim.x * NWV;
    for (int tile0 = blockIdx.x * NWV + wid; tile0 < (tn_only >= 0 ? T_ / 64 : ntiles); tile0 += nw) {
        const int tile = tn_only >= 0 ? tile0 * nTn + tn_only : tile0;
        const int tm = tile / nTn, tn = tile - tm * nTn, m0 = tm * 64, n0 = tn * 64;
        bool swp = false;
        if (MODE == 0) swp = (tn >= 40 && tn < 48);
        if (MODE == 1) swp = (tn >= 28 && tn < 32) || (tn >= 36 && tn < 40);
        f32x16 acc[2][2];
        if (swp) {
            gemm_core<true>(A, Bt, D_, m0, n0, acc, r, h);
            int vb, nh; bf16_t* dst;
            if (MODE == 0) { vb = 2560; nh = 8; dst = p.vT; } else if (tn < 32) { vb = 1792; nh = 4; dst = p.vT; } else { vb = 2304; nh = 4; dst = p.vT + (size_t)B_ * 4 * 64 * S_; }
#pragma unroll
            for (int i = 0; i < 2; ++i) {
                const int m = m0 + 32 * i + r, b = m >> 11, s = m & 2047;
#pragma unroll
                for (int j = 0; j < 2; ++j)
#pragma unroll
                    for (int q = 0; q < 16; ++q) {
                        const int n = n0 + 32 * j + rowmap(q, h) - vb; const int hd = n >> 6, d = n & 63;
                        dst[(size_t)(b * nh + hd) * 64 * S_ + vtile_elem(s, d)] = f_to_bf(acc[i][j][q]);
                    }
            }
        } else {
            gemm_core<false>(A, Bt, D_, m0, n0, acc, r, h);
#pragma unroll
            for (int i = 0; i < 2; ++i)
#pragma unroll
                for (int j = 0; j < 2; ++j)
#pragma unroll
                    for (int q = 0; q < 16; ++q) {
                        const int m = m0 + 32 * i + rowmap(q, h), n = n0 + 32 * j + r; const float v = acc[i][j][q];
                        if (MODE == 0) {
                            if (n < EVEN_LD) p.proj[(size_t)m * EVEN_LD + n] = f_to_bf(v);
                            else if (n < EVEN_N) p.fg[(size_t)m * 8 + (n - EVEN_LD)] = v;
                        } else if (MODE == 1) {
                            if (n < ODD_LD) p.proj[(size_t)m * ODD_LD + n] = f_to_bf(v);
                            else if (n < ODD_N) p.fg[(size_t)m * 48 + (n - ODD_LD)] = v;
                        } else if (MODE == 2) {
                            const float* xo = (layer == 0) ? p.x : p.out;
                            const float g1 = p.mods[((size_t)layer * B_ + (m >> 11)) * 6144 + 2048 + n];
                            p.out[(size_t)m * D_ + n] = xo[(size_t)m * D_ + n] + g1 * v;
                        } else {
                            ((bf16_t*)p.qp)[(size_t)m * D_ + n] = f_to_bf(v);
                        }
                    }
        }
    }
}


template <int MODE>
__device__ __forceinline__ void phase_gemm(const P& p, int layer, char* lds, int wv) {
#if MK_SIMPLE_GEMM
    phase_gemm_simple<MODE>(p, layer, -1, wv);
#else
    const int li = layer >> 1;
    PG8_LAS unsigned char* l3 = (PG8_LAS unsigned char*)lds;
    pg8::StaticOrder S;
    if (MODE == 0) {
        pg8::Gemm g{p.h, p.winE + (size_t)li * EVEN_NP * D_, T_, EVEN_LD, D_}; S.init(T_, EVEN_LD, gridDim.x, blockIdx.x);
        EpiIn<EVEN_LD, -1, 8> E{p.proj, nullptr};
        pg8::gemm_phase<EpiIn<EVEN_LD, -1, 8>, pg8::StaticOrder, true, true>(l3, g, S, E, wv);
    } else if (MODE == 1) {
        pg8::Gemm g{p.h, p.winO + (size_t)li * ODD_NP * D_, T_, ODD_NP, D_}; S.init(T_, ODD_NP, gridDim.x, blockIdx.x);
        EpiIn<ODD_LD, 10, 48> E{p.proj, p.fg};
        pg8::gemm_phase<EpiIn<ODD_LD, 10, 48>, pg8::StaticOrder, true, true>(l3, g, S, E, wv);
    } else if (MODE == 2) {
        pg8::Gemm g{p.cat, ((layer & 1) ? p.woutO : p.woutE) + (size_t)li * D_ * D_, T_, D_, D_}; S.init(T_, D_, gridDim.x, blockIdx.x);
        EpiOut E{(layer == 0) ? p.x : p.out, p.out, p.mods + (size_t)layer * B_ * 6144 + 2048};
        pg8::gemm_phase<EpiOut, pg8::StaticOrder, true, true>(l3, g, S, E, wv);
    } else {
        pg8::Gemm g{p.h, p.wq + (size_t)layer * D_ * D_, T_, D_, D_}; S.init(T_, D_, gridDim.x, blockIdx.x);
        EpiIn<D_, -1, 8> E{(bf16_t*)p.qp, nullptr};
        pg8::gemm_phase<EpiIn<D_, -1, 8>, pg8::StaticOrder, true, true>(l3, g, S, E, wv);
    }
#endif
}

__device__ __forceinline__ void convT(const float* src, int K, int N, int NP, bf16_t* dst, float* lt, int tid) {
    const int tk = K / 64, tnn = NP / 64;
    for (int tile = blockIdx.x; tile < tk * tnn; tile += gridDim.x) {
        const int k0 = (tile % tk) * 64, n0 = (tile / tk) * 64;
#pragma unroll
        for (int i = 0; i < 8; ++i) { const int idx = tid + NTHR * i, kk = idx >> 6, nn = idx & 63; lt[nn * 65 + kk] = (n0 + nn < N) ? src[(size_t)(k0 + kk) * N + n0 + nn] : 0.f; }
        __syncthreads();
#pragma unroll
        for (int i = 0; i < 4; ++i) { const int idx = tid + NTHR * i, nn = idx >> 5, kp = (idx & 31) * 2;
            *(unsigned*)(dst + (size_t)(n0 + nn) * K + k0 + kp) = cvt_pk_bf16(lt[nn * 65 + kp], lt[nn * 65 + kp + 1]); }
        __syncthreads();
    }
}
__device__ __forceinline__ void conv_plain(const float* src, bf16_t* dst, size_t n, int tid) {
    const size_t nth = (size_t)gridDim.x * NTHR;
    for (size_t i = (size_t)blockIdx.x * NTHR + tid; i < n / 8; i += nth) {
        const f32x4 a = *(const f32x4*)(src + i * 8), b = *(const f32x4*)(src + i * 8 + 4);
        u32x4 w; w.x = cvt_pk_bf16(a[0], a[1]); w.y = cvt_pk_bf16(a[2], a[3]); w.z = cvt_pk_bf16(b[0], b[1]); w.w = cvt_pk_bf16(b[2], b[3]);
        *(u32x4*)(dst + i * 8) = w;
    }
}
constexpr float V6_SCALE = 4.f;
constexpr float U6_SCALE = 48.f;
__device__ __forceinline__ unsigned enc_e2m3(float x) {
    const unsigned s = (__float_as_uint(x) >> 26) & 0x20u;
    const float a = fminf(fabsf(x), 7.5f);
    const unsigned b = __float_as_uint(a);
    const unsigned cn = ((b + 0x7ffffu + ((b >> 20) & 1u)) >> 20) - (126u << 3);
    const unsigned cs = (unsigned)__builtin_rintf(a * 8.f);
    const unsigned c = (a < 1.f) ? cs : cn;
    return s | (c > 31u ? 31u : c);
}
__device__ __forceinline__ float dec_e2m3(unsigned c) {
    const unsigned c5 = c & 31u;
    const float mag = (c5 < 8u) ? (float)c5 * 0.125f : __uint_as_float((c5 + (126u << 3)) << 20);
    return (c & 32u) ? -mag : mag;
}
__device__ __forceinline__ void conv_fp6_sliced(const float* src, unsigned char* dst, float scale, int tid) {
    const size_t nth = (size_t)gridDim.x * NTHR, n16 = (size_t)4 * 16384 * 64;
    for (size_t i = (size_t)blockIdx.x * NTHR + tid; i < n16; i += nth) {
        const size_t row = i >> 6; const int ch = (int)(i & 63);
        v16f32 ev = {}, od = {};
#pragma unroll
        for (int q = 0; q < 4; ++q) { const f32x4 a = *(const f32x4*)(src + row * D_ + ch * 16 + 4 * q);
            ev[2 * q] = a[0] * scale; od[2 * q] = a[1] * scale; ev[2 * q + 1] = a[2] * scale; od[2 * q + 1] = a[3] * scale; }
        const v6u32 pk = __builtin_amdgcn_cvt_scalef32_2xpk16_fp6_f32(ev, od, 1.0f);
        const size_t layer = row >> 14, ex = row & 16383;
        unsigned* d = (unsigned*)(dst + ((layer * 4 + (ch >> 4)) * 16384 + ex) * 192 + (ch & 15) * 12);
        d[0] = pk[0]; d[1] = pk[1]; d[2] = pk[2];
    }
}
__device__ __forceinline__ void conv_fp6(const float* src, unsigned char* dst, size_t nrows, float scale, int tid) {
    const size_t nth = (size_t)gridDim.x * NTHR;
    for (size_t i = (size_t)blockIdx.x * NTHR + tid; i < nrows * 64; i += nth) {
        const size_t row = i >> 6; const int ch = (int)(i & 63);
        v16f32 ev = {}, od = {};
#pragma unroll
        for (int q = 0; q < 4; ++q) { const f32x4 a = *(const f32x4*)(src + row * D_ + ch * 16 + 4 * q);
            ev[2 * q] = a[0] * scale; od[2 * q] = a[1] * scale; ev[2 * q + 1] = a[2] * scale; od[2 * q + 1] = a[3] * scale; }
        const v6u32 pk = __builtin_amdgcn_cvt_scalef32_2xpk16_fp6_f32(ev, od, 1.0f);
        unsigned* d = (unsigned*)(dst + row * 768 + ch * 12);
        d[0] = pk[0]; d[1] = pk[1]; d[2] = pk[2];
    }
}
__device__ __forceinline__ void phase_prologue(const P& p, char* lds, int wv) {
    float* lt = (float*)lds;
    const int tid = opaque_tid(wv);
    for (int i = 0; i < 2; ++i) {
        convT(p.e_w_in + (size_t)i * D_ * EVEN_N, D_, EVEN_N, EVEN_NP, p.winE + (size_t)i * EVEN_NP * D_, lt, tid);
        convT(p.e_w_out + (size_t)i * D_ * D_, D_, D_, D_, p.woutE + (size_t)i * D_ * D_, lt, tid);
        convT(p.o_w_in + (size_t)i * D_ * ODD_N, D_, ODD_N, ODD_NP, p.winO + (size_t)i * ODD_NP * D_, lt, tid);
        convT(p.o_w_out + (size_t)i * D_ * D_, D_, D_, D_, p.woutO + (size_t)i * D_ * D_, lt, tid);
        for (int kv = 0; kv < 2; ++kv) {
            convT(p.o_cmp_w1 + (size_t)(i * 2 + kv) * 2048 * 64, 2048, 64, 64, p.w1t + (size_t)(i * 2 + kv) * 64 * 2048, lt, tid);
            convT(p.o_cmp_w2 + (size_t)(i * 2 + kv) * 64 * 64, 64, 64, 64, p.w2t + (size_t)(i * 2 + kv) * 64 * 64, lt, tid);
        }
    }
    for (int l = 0; l < 4; ++l) convT(p.p_w_q + (size_t)l * D_ * D_, D_, D_, D_, p.wq + (size_t)l * D_ * D_, lt, tid);
    conv_fp6(p.p_u, p.u8, (size_t)4 * 16384, U6_SCALE, tid);
    conv_fp6_sliced(p.p_v, p.v8, V6_SCALE, tid);
    conv_plain(p.p_keys, p.keys16, (size_t)4 * 2 * 128 * 64, tid);
    for (int u = (int)gridDim.x - 1 - (int)blockIdx.x; u < 4; u += gridDim.x) {
        const int cc = tid & 63, ch = tid >> 6; float s = 0.f;
        const float* pos = p.o_cmp_pos + (size_t)u * 2048; const float* w1 = p.o_cmp_w1 + (size_t)u * 2048 * 64;
        for (int k0 = ch * 256; k0 < ch * 256 + 256; k0 += 16) {
            float pv[16], wv16[16];
#pragma unroll
            for (int q = 0; q < 16; ++q) { pv[q] = pos[k0 + q]; wv16[q] = w1[(size_t)(k0 + q) * 64 + cc]; }
#pragma unroll
            for (int q = 0; q < 16; ++q) s += pv[q] * wv16[q];
        }
        __syncthreads(); lt[tid] = s; __syncthreads();
        if (tid < 64) { float t = 0.f; for (int q = 0; q < 8; ++q) t += lt[q * 64 + tid]; p.c1[u * 64 + tid] = t; }
        __syncthreads();
    }
    __syncthreads();
    for (int i = tid; i < 8 * D_; i += NTHR) { const float cv = p.c[i]; lt[i] = cv / (1.f + __expf(-cv)); }
    float* part = lt + 8 * D_;
    __syncthreads();
    for (int u = blockIdx.x; u < 4 * 48; u += gridDim.x) {
        const int l = u / 48, ec = u % 48, col = tid & 127, dq = tid >> 7, e = ec * 128 + col;
        float acc[8];
#pragma unroll
        for (int b = 0; b < 8; ++b) acc[b] = 0.f;
        const float* w = p.ada_w + ((size_t)l * D_ + dq * 256) * 6144 + e;
        for (int d0 = 0; d0 < 256; d0 += 16) {
            float wv[16];
#pragma unroll
            for (int q = 0; q < 16; ++q) wv[q] = w[(size_t)(d0 + q) * 6144];
#pragma unroll
            for (int q = 0; q < 16; q += 4)
#pragma unroll
                for (int b = 0; b < 8; ++b) { const f32x4 sv = *(const f32x4*)(lt + b * D_ + dq * 256 + d0 + q); acc[b] += sv[0] * wv[q] + sv[1] * wv[q + 1] + sv[2] * wv[q + 2] + sv[3] * wv[q + 3]; }
        }
#pragma unroll
        for (int b = 0; b < 8; ++b) part[(dq * 8 + b) * 128 + col] = acc[b];
        __syncthreads();
        for (int i = tid; i < 8 * 128; i += NTHR) { const int b = i >> 7, cc = i & 127;
            const float s = ((part[(0 * 8 + b) * 128 + cc] + part[(1 * 8 + b) * 128 + cc]) + part[(2 * 8 + b) * 128 + cc]) + part[(3 * 8 + b) * 128 + cc];
            p.mods[((size_t)l * B_ + b) * 6144 + ec * 128 + cc] = s + p.ada_b[l * 6144 + ec * 128 + cc]; }
        __syncthreads();
    }
}

__device__ __forceinline__ void phase_norm(const P& p, int layer, int which, int wv) {
    const int tid = opaque_tid(wv), lane = tid & 63, wid = __builtin_amdgcn_readfirstlane(tid >> 6);
    const bool gates = (which == 0) && ((layer & 1) == 0);
    u32x2 wf[8][4];
    if (gates) {
#pragma unroll
        for (int c = 0; c < 8; ++c)
#pragma unroll
            for (int i = 0; i < 4; ++i) wf[c][i] = *(const u32x2*)(p.winE + ((size_t)(layer >> 1) * EVEN_NP + EVEN_LD + c) * D_ + 4 * lane + 256 * i);
    }
    const float* xin = (layer == 0 && which == 0) ? p.x : p.out;
    const float* gain = p.norm_g + (size_t)(layer * 2 + which) * D_;
    const int t0_ = blockIdx.x * NWV + wid, tstep_ = gridDim.x * NWV;
    f32x4 vn[4];
#pragma unroll
    for (int i = 0; i < 4; ++i) vn[i] = *(const f32x4*)(xin + (size_t)(t0_ < T_ ? t0_ : 0) * D_ + 4 * lane + 256 * i);
    for (int t = t0_; t < T_; t += tstep_) {
        const int b = t >> 11;
        const float* md = p.mods + ((size_t)layer * B_ + b) * 6144 + which * 3072;
        f32x4 v[4]; float ss = 0.f;
        const int tnx = (t + tstep_ < T_) ? t + tstep_ : t;
#pragma unroll
        for (int i = 0; i < 4; ++i) { v[i] = vn[i]; vn[i] = *(const f32x4*)(xin + (size_t)tnx * D_ + 4 * lane + 256 * i); ss += v[i][0] * v[i][0] + v[i][1] * v[i][1] + v[i][2] * v[i][2] + v[i][3] * v[i][3]; }
        ss = wave_sum(ss);
        const float rs = rsqrtf(ss * (1.f / D_) + 1e-6f);
        float fd[8];
        float yk[4][4], amax = 1e-30f;
#pragma unroll
        for (int c = 0; c < 8; ++c) fd[c] = 0.f;
#pragma unroll
        for (int i = 0; i < 4; ++i) {
            const int e = 4 * lane + 256 * i;
            const f32x4 g = *(const f32x4*)(gain + e), sh = *(const f32x4*)(md + e), sc = *(const f32x4*)(md + 1024 + e);
            float y[4];
#pragma unroll
            for (int q = 0; q < 4; ++q) y[q] = v[i][q] * rs * g[q] * (1.f + sc[q]) + sh[q];
            u32x2 w; w.x = cvt_pk_bf16(y[0], y[1]); w.y = cvt_pk_bf16(y[2], y[3]);
            *(u32x2*)(p.h + (size_t)t * D_ + e) = w;
            if (which == 1) {
#pragma unroll
                for (int q = 0; q < 4; ++q) { yk[i][q] = y[q]; amax = fmaxf(amax, fabsf(y[q])); }
            }
            if (gates) {
#pragma unroll
                for (int c = 0; c < 8; ++c) fd[c] += bf_lo(w.x) * bf_lo(wf[c][i].x) + bf_hi(w.x) * bf_hi(wf[c][i].x) + bf_lo(w.y) * bf_lo(wf[c][i].y) + bf_hi(w.y) * bf_hi(wf[c][i].y);
            }
        }
        if (which == 1) {
            const float am = wave_max(amax), sc = 7.5f / am;
#pragma unroll
            for (int i = 0; i < 4; ++i) {
                unsigned hi = 0u, lo = 0u;
#pragma unroll
                for (int q = 0; q < 4; ++q) {
                    const float a = yk[i][q] * sc; const unsigned ch = enc_e2m3(a), c5 = ch & 31u;
                    const float mag = (c5 < 8u) ? (float)c5 * 0.125f : __uint_as_float((c5 + (126u << 3)) << 20);
                    const float back = (ch & 32u) ? -mag : mag;
                    hi |= ch << (8 * q); lo |= enc_e2m3(a - back) << (8 * q);
                }
                *(unsigned*)(p.h8 + (size_t)t * 2048 + 4 * lane + 256 * i) = hi; *(unsigned*)(p.h8 + (size_t)t * 2048 + 1024 + 4 * lane + 256 * i) = lo;
            }
            if (lane == 0) p.hinv[t] = am * (1.f / 7.5f);
        }
        if (gates) {
            float mine = 0.f;
#pragma unroll
            for (int c = 0; c < 8; ++c) { const float s = wave_sum(fd[c]); mine = (lane == c) ? s : mine; }
            if (lane < 8) p.fg[(size_t)t * 8 + lane] = mine;
        }
    }
}

__device__ __forceinline__ float q_e2m3(float a) {
    const float m = fminf(fabsf(a), 7.5f);
    const unsigned b = __float_as_uint(m);
    const float qn = __uint_as_float((b + 0x7ffffu + ((b >> 20) & 1u)) & 0xfff00000u);
    const float qs = __builtin_rintf(m * 8.f) * 0.125f;
    const float q = fminf((m < 1.f) ? qs : qn, 7.5f);
    return __builtin_copysignf(q, a);
}
__device__ __forceinline__ void phase_norm2(const P& p, int layer, int wv) {
    const int tid = opaque_tid(wv), lane = tid & 63, wid = __builtin_amdgcn_readfirstlane(tid >> 6);
    const float* xin = p.out;
    const float* gain = p.norm_g + (size_t)(layer * 2 + 1) * D_ + 16 * lane;
    f32x4 g[4];
#pragma unroll
    for (int i = 0; i < 4; ++i) g[i] = *(const f32x4*)(gain + 4 * i);
    const int t0_ = blockIdx.x * NWV + wid, tstep_ = gridDim.x * NWV;
    f32x4 vn[4];
#pragma unroll
    for (int i = 0; i < 4; ++i) vn[i] = *(const f32x4*)(xin + (size_t)(t0_ < T_ ? t0_ : 0) * D_ + 16 * lane + 4 * i);
    for (int t = t0_; t < T_; t += tstep_) {
        const int b = t >> 11;
        const float* md = p.mods + ((size_t)layer * B_ + b) * 6144 + 3072 + 16 * lane;
        f32x4 v[4]; float ss = 0.f;
        const int tnx = (t + tstep_ < T_) ? t + tstep_ : t;
#pragma unroll
        for (int i = 0; i < 4; ++i) { v[i] = vn[i]; vn[i] = *(const f32x4*)(xin + (size_t)tnx * D_ + 16 * lane + 4 * i); ss += v[i][0] * v[i][0] + v[i][1] * v[i][1] + v[i][2] * v[i][2] + v[i][3] * v[i][3]; }
        ss = wave_sum(ss);
        const float rs = rsqrtf(ss * (1.f / D_) + 1e-6f);
        float y[16], amax = 1e-30f;
        unsigned hw[8];
#pragma unroll
        for (int i = 0; i < 4; ++i) {
            const f32x4 sh = *(const f32x4*)(md + 4 * i), sc = *(const f32x4*)(md + 1024 + 4 * i);
#pragma unroll
            for (int q = 0; q < 4; ++q) { y[4 * i + q] = v[i][q] * rs * g[i][q] * (1.f + sc[q]) + sh[q]; amax = fmaxf(amax, fabsf(y[4 * i + q])); }
            hw[2 * i] = cvt_pk_bf16(y[4 * i], y[4 * i + 1]); hw[2 * i + 1] = cvt_pk_bf16(y[4 * i + 2], y[4 * i + 3]);
        }
        *(u32x4*)(p.h + (size_t)t * D_ + 16 * lane) = (u32x4){hw[0], hw[1], hw[2], hw[3]}; *(u32x4*)(p.h + (size_t)t * D_ + 16 * lane + 8) = (u32x4){hw[4], hw[5], hw[6], hw[7]};
        const float am = wave_max(amax), scl = 7.5f / am;
        v16f32 eh = {}, oh = {}, el = {}, ol = {};
#pragma unroll
        for (int i = 0; i < 8; ++i) {
            const float a0 = y[2 * i] * scl, a1 = y[2 * i + 1] * scl;
            eh[i] = a0; oh[i] = a1; el[i] = a0 - q_e2m3(a0); ol[i] = a1 - q_e2m3(a1);
        }
        const v6u32 ph = __builtin_amdgcn_cvt_scalef32_2xpk16_fp6_f32(eh, oh, 1.0f), pl = __builtin_amdgcn_cvt_scalef32_2xpk16_fp6_f32(el, ol, 1.0f);
        unsigned* d = (unsigned*)(p.h8 + (size_t)t * 1536 + 24 * lane);
        *(u32x2*)d = (u32x2){ph[0], ph[1]}; *(u32x2*)(d + 2) = (u32x2){ph[2], pl[0]}; *(u32x2*)(d + 4) = (u32x2){pl[1], pl[2]};
        if (lane == 0) p.hinv[t] = am * (1.f / 7.5f);
    }
}

__device__ __forceinline__ void unpack8(u32x4 w, float (&f)[8]) { f[0] = bf_lo(w.x); f[1] = bf_hi(w.x); f[2] = bf_lo(w.y); f[3] = bf_hi(w.y); f[4] = bf_lo(w.z); f[5] = bf_hi(w.z); f[6] = bf_lo(w.w); f[7] = bf_hi(w.w); }
__device__ __forceinline__ u32x4 pack8(const float (&f)[8]) { u32x4 w; w.x = cvt_pk_bf16(f[0], f[1]); w.y = cvt_pk_bf16(f[2], f[3]); w.z = cvt_pk_bf16(f[4], f[5]); w.w = cvt_pk_bf16(f[6], f[7]); return w; }
__device__ __forceinline__ void headnorm8(bf16_t* ptr, const float* gain8, bf16_t* dst = nullptr) {
    float f[8]; unpack8(*(const u32x4*)ptr, f);
    float ss = 0.f;
#pragma unroll
    for (int q = 0; q < 8; ++q) ss += f[q] * f[q];
    ss = oct_sum(ss);
    const float rs = rsqrtf(ss * (1.f / 64.f) + 1e-6f);
#pragma unroll
    for (int q = 0; q < 8; ++q) f[q] = f[q] * rs * gain8[q];
    *(u32x4*)(dst ? dst : ptr) = pack8(f);
}
__device__ __forceinline__ void v_tile8(const bf16_t* src, int ld, bf16_t* dstbase, int s0, int dd0) {
    u32x4 tk[8];
#pragma unroll
    for (int i = 0; i < 8; ++i) tk[i] = *(const u32x4*)(src + (size_t)i * ld);
#pragma unroll
    for (int e = 0; e < 8; ++e) {
        u32x4 o;
#pragma unroll
        for (int pq = 0; pq < 4; ++pq) {
            const unsigned a = tk[2 * pq][e >> 1], b = tk[2 * pq + 1][e >> 1];
            o[pq] = (e & 1) ? ((a >> 16) | (b & 0xffff0000u)) : ((a & 0xffffu) | (b << 16));
        }
        *(u32x4*)(dstbase + vtile_elem(s0, dd0 + e)) = o;
    }
}
__device__ __forceinline__ void phase_post_even(const P& p, int layer, int wv) {
    const int tid = opaque_tid(wv), lane = tid & 63, wid = __builtin_amdgcn_readfirstlane(tid >> 6), li = layer >> 1;
    const float* cw = p.e_conv_w + (size_t)li * 3 * 512;
    const int c0 = 8 * lane;
    float w0[8], w1[8], w2[8], qg[8], kg[8];
#pragma unroll
    for (int q = 0; q < 8; ++q) { w0[q] = cw[c0 + q]; w1[q] = cw[512 + c0 + q]; w2[q] = cw[1024 + c0 + q]; qg[q] = p.e_q_g[li * 64 + ((c0 + q) & 63)]; kg[q] = p.e_k_g[li * 64 + ((c0 + q) & 63)]; }
    const int gw = blockIdx.x * NWV + wid, nw = gridDim.x * NWV;
    for (int t = gw; t < T_; t += nw) {
        const int s = t & 2047;
        bf16_t* row = p.proj + (size_t)t * EVEN_LD;
        float cb[8], a[8], b[8], u0[8], u1[8], u2[8];
        unpack8(*(const u32x4*)(row + c0), cb);
        unpack8(*(const u32x4*)(row + 512 + c0), a); unpack8(*(const u32x4*)(row + 1024 + c0), b);
#pragma unroll
        for (int q = 0; q < 8; ++q) u0[q] = a[q] * b[q];
        if (s >= 1) { unpack8(*(const u32x4*)(row - EVEN_LD + 512 + c0), a); unpack8(*(const u32x4*)(row - EVEN_LD + 1024 + c0), b);
#pragma unroll
            for (int q = 0; q < 8; ++q) u1[q] = a[q] * b[q]; }
        else {
#pragma unroll
            for (int q = 0; q < 8; ++q) u1[q] = 0.f; }
        if (s >= 2) { unpack8(*(const u32x4*)(row - 2 * EVEN_LD + 512 + c0), a); unpack8(*(const u32x4*)(row - 2 * EVEN_LD + 1024 + c0), b);
#pragma unroll
            for (int q = 0; q < 8; ++q) u2[q] = a[q] * b[q]; }
        else {
#pragma unroll
            for (int q = 0; q < 8; ++q) u2[q] = 0.f; }
        float o[8];
#pragma unroll
        for (int q = 0; q < 8; ++q) o[q] = cb[q] * (w0[q] * u2[q] + w1[q] * u1[q] + w2[q] * u0[q]);
        *(u32x4*)(p.cat + (size_t)t * D_ + c0) = pack8(o);
        headnorm8(row + 1536 + c0, qg);
        headnorm8(row + 2048 + c0, kg, p.kt + (size_t)((t >> 11) * 8 + (lane >> 3)) * 64 * S_ + ktile_elem(s, c0 & 63));
    }
    for (int grp = gw; grp < T_ / 8; grp += nw) {
        const int t0 = grp * 8;
        v_tile8(p.proj + (size_t)t0 * EVEN_LD + 2560 + c0, EVEN_LD, p.vT + (size_t)((t0 >> 11) * 8 + (lane >> 3)) * 64 * S_, t0 & 2047, c0 & 63);
    }
    for (int sq = gw; sq < 64; sq += nw) {
        const int b = sq >> 3, hd = sq & 7; const float bf = p.e_b_f[li * 8 + hd];
        float v[32]; float run = 0.f;
#pragma unroll
        for (int i = 0; i < 32; ++i) {
            const float z = p.fg[((size_t)b * S_ + lane * 32 + i) * 8 + hd] + bf;
            const float ls = fminf(z, 0.f) - log1pf(expf(-fabsf(z)));
            run += ls; v[i] = run;
        }
        float incl = run;
#pragma unroll
        for (int d = 1; d < 64; d <<= 1) { const float o = __shfl_up(incl, d); if (lane >= d) incl += o; }
        const float excl = incl - run;
#pragma unroll
        for (int i = 0; i < 32; ++i) p.cum[(size_t)sq * S_ + lane * 32 + i] = (v[i] + excl) * LOG2E;
    }
}

struct AttnAcc { f32x16 o[2]; float m, l; };
__device__ __forceinline__ void attn_init(AttnAcc& a) {
#pragma unroll
    for (int q = 0; q < 16; ++q) { a.o[0][q] = 0.f; a.o[1][q] = 0.f; }
    a.m = -INFINITY; a.l = 0.f;
}
__device__ __forceinline__ f32x16 attn_scores(const bf16_t* kbase, int ldk, const bf16x8 (&qf)[4], int r, int h) {
    const bf16_t* kp = kbase + (size_t)swap23(r) * ldk + 8 * h;
    bf16x8 kf[4];
#pragma unroll
    for (int ks = 0; ks < 4; ++ks) kf[ks] = ld8(kp + 16 * ks);
    f32x16 s;
#pragma unroll
    for (int q = 0; q < 16; ++q) s[q] = 0.f;
#pragma unroll
    for (int ks = 0; ks < 4; ++ks) s = mfma32(kf[ks], qf[ks], s);
    return s;
}
__device__ __forceinline__ void attn_update(AttnAcc& a, const f32x16& s, const bf16_t* vt, int ldv, int r, int h) {
    bf16x8 vf[2][2];
#pragma unroll
    for (int db = 0; db < 2; ++db)
#pragma unroll
        for (int ks = 0; ks < 2; ++ks) vf[db][ks] = ld8(vt + (size_t)(32 * db + r) * ldv + 16 * ks + 8 * h);
    float mx = s[0];
#pragma unroll
    for (int q = 1; q < 16; ++q) mx = fmaxf(mx, s[q]);
    mx = fmaxf(mx, __shfl_xor(mx, 32));
    const float mn = fmaxf(a.m, mx), ms = (mn == -INFINITY) ? 0.f : mn;
    const float alpha = __expf(a.m - ms);
    float pv[16], ps = 0.f;
#pragma unroll
    for (int q = 0; q < 16; ++q) { pv[q] = __expf(s[q] - ms); ps += pv[q]; }
    a.l = a.l * alpha + ps; a.m = mn;
#pragma unroll
    for (int q = 0; q < 16; ++q) { a.o[0][q] *= alpha; a.o[1][q] *= alpha; }
    union { bf16x8 v; unsigned u[4]; } pf[2];
#pragma unroll
    for (int ks = 0; ks < 2; ++ks)
#pragma unroll
        for (int q = 0; q < 4; ++q) pf[ks].u[q] = cvt_pk_bf16(pv[8 * ks + 2 * q], pv[8 * ks + 2 * q + 1]);
#pragma unroll
    for (int db = 0; db < 2; ++db)
#pragma unroll
        for (int ks = 0; ks < 2; ++ks) a.o[db] = mfma32(vf[db][ks], pf[ks].v, a.o[db]);
}

struct KF { bf16x8 k[4]; };
struct VF { bf16x8 v[2][2]; };
typedef __amdgpu_buffer_rsrc_t rsrc_t;
__device__ __forceinline__ rsrc_t mk_rsrc(const void* base, unsigned bytes) { return __builtin_amdgcn_make_buffer_rsrc((void*)base, 0, bytes, 0x00020000); }
__device__ __forceinline__ bf16x8 bld8(rsrc_t rs, unsigned voff, unsigned soff) { return __builtin_bit_cast(bf16x8, __builtin_amdgcn_raw_buffer_load_b128(rs, voff, soff, 0)); }
__device__ __forceinline__ void k_load(KF& f, rsrc_t rs, unsigned lo16, unsigned sk) {
    sk = __builtin_amdgcn_readfirstlane(sk);
#pragma unroll
    for (int ks = 0; ks < 4; ++ks) f.k[ks] = bld8(rs, lo16, sk + 1024 * ks);
}
__device__ __forceinline__ void v_load(VF& f, rsrc_t rs, unsigned lo16, unsigned sv) {
    sv = __builtin_amdgcn_readfirstlane(sv);
#pragma unroll
    for (int db = 0; db < 2; ++db)
#pragma unroll
        for (int ks = 0; ks < 2; ++ks) f.v[db][ks] = bld8(rs, lo16, sv + 1024 * (db * 2 + ks));
}
__device__ __forceinline__ f32x16 kv_scores(const KF& f, const bf16x8 (&qf)[4]) {
    f32x16 s;
#pragma unroll
    for (int q = 0; q < 16; ++q) s[q] = 0.f;
#pragma unroll
    for (int ks = 0; ks < 4; ++ks) s = mfma32(f.k[ks], qf[ks], s);
    return s;
}
__device__ __forceinline__ void kv_update(AttnAcc& a, const f32x16& s, const VF& f) {
    float mx = s[0];
#pragma unroll
    for (int q = 1; q < 16; ++q) mx = fmaxf(mx, s[q]);
    mx = fmaxf(mx, __shfl_xor(mx, 32));
    const float mn = fmaxf(a.m, mx), ms = (mn == -INFINITY) ? 0.f : mn;
    const float alpha = __expf(a.m - ms);
    float pv[16], ps = 0.f;
#pragma unroll
    for (int q = 0; q < 16; ++q) { pv[q] = __expf(s[q] - ms); ps += pv[q]; }
    a.l = a.l * alpha + ps; a.m = mn;
#pragma unroll
    for (int q = 0; q < 16; ++q) { a.o[0][q] *= alpha; a.o[1][q] *= alpha; }
    union { bf16x8 v; unsigned u[4]; } pf[2];
#pragma unroll
    for (int ks = 0; ks < 2; ++ks)
#pragma unroll
        for (int q = 0; q < 4; ++q) pf[ks].u[q] = cvt_pk_bf16(pv[8 * ks + 2 * q], pv[8 * ks + 2 * q + 1]);
#pragma unroll
    for (int db = 0; db < 2; ++db)
#pragma unroll
        for (int ks = 0; ks < 2; ++ks) a.o[db] = mfma32(f.v[db][ks], pf[ks].v, a.o[db]);
}

struct AccF { f32x16 o[2]; float l; };
__device__ __forceinline__ void accf_init(AccF& a) {
#pragma unroll
    for (int q = 0; q < 16; ++q) { a.o[0][q] = 0.f; a.o[1][q] = 0.f; }
    a.l = 0.f;
}
__device__ __forceinline__ void kv_update_fixed(AccF& a, const float (&pv)[16], const VF& f) {
    float ps = 0.f;
#pragma unroll
    for (int q = 0; q < 16; ++q) ps += pv[q];
    a.l += ps;
    union { bf16x8 v; unsigned u[4]; } pf[2];
#pragma unroll
    for (int ks = 0; ks < 2; ++ks)
#pragma unroll
        for (int q = 0; q < 4; ++q) pf[ks].u[q] = cvt_pk_bf16(pv[8 * ks + 2 * q], pv[8 * ks + 2 * q + 1]);
#pragma unroll
    for (int db = 0; db < 2; ++db)
#pragma unroll
        for (int ks = 0; ks < 2; ++ks) a.o[db] = mfma32(f.v[db][ks], pf[ks].v, a.o[db]);
}
__device__ __forceinline__ void phase_fox(const P& p, int layer, int wv) {
    const int tid = opaque_tid(wv), lane = tid & 63, wid = __builtin_amdgcn_readfirstlane(tid >> 6), r = lane & 31, h = lane >> 5, li = layer >> 1;
    const int nw = gridDim.x * NWV;
    const float M2 = 8.f * wave_max(fabsf(p.e_q_g[li * 64 + lane])) * wave_max(fabsf(p.e_k_g[li * 64 + lane])) * LOG2E;
    const float c1 = 0.125f * LOG2E;
    for (int u0 = blockIdx.x * NWV + wid; u0 < 2048; u0 += nw) {
        int u = u0;
        if (gridDim.x == 256) { const int xg = blockIdx.x & 7, w = (blockIdx.x >> 3) * NWV + wid; u = ((xg * 8 + (w >> 5)) << 5) | (w & 31); }
        const int b = u >> 8, hd = (u >> 5) & 7, ii = u & 31;
        const float* cumrow = p.cum + (size_t)(b * 8 + hd) * S_;
        const rsrc_t rsK = mk_rsrc(p.kt, (unsigned)((size_t)T_ * 512 * 2)), rsV = mk_rsrc(p.vT, (unsigned)((size_t)T_ * 512 * 2));
        const unsigned kb = (unsigned)((size_t)(b * 8 + hd) * 64 * S_ * 2), vtb = kb;
        for (int half = 0; half < 2; ++half) {
            const int qt = half ? (63 - ii) : ii, q0 = qt * 32, tq = q0 + r;
            const size_t t = (size_t)b * S_ + tq;
            bf16x8 qf[4];
#pragma unroll
            for (int ks = 0; ks < 4; ++ks) qf[ks] = ld8(p.proj + t * EVEN_LD + 1536 + hd * 64 + 16 * ks + 8 * h);
            const float ctm = cumrow[tq] - M2;
            int rdiag = r - 8 * h; asm volatile("" : "+v"(rdiag));
            AccF a; accf_init(a);
            KF cur, nxt; VF vcur, vnxt; f32x4 cc[4], cn[4];
            const unsigned lo16 = (unsigned)lane * 16u;
            k_load(cur, rsK, lo16, kb); v_load(vcur, rsV, lo16, vtb);
#pragma unroll
            for (int q = 0; q < 4; ++q) cc[q] = *(const f32x4*)(cumrow + 16 * (q >> 1) + 8 * h + 4 * (q & 1));
#pragma unroll 1
            for (int k0 = 0; k0 <= q0; k0 += 32) {
                { const int kn = (k0 + 32 <= q0) ? k0 + 32 : k0;
                    v_load(vnxt, rsV, lo16, vtb + (unsigned)kn * 128u);
                    k_load(nxt, rsK, lo16, kb + (unsigned)kn * 128u);
#pragma unroll
                    for (int q = 0; q < 4; ++q) cn[q] = *(const f32x4*)(cumrow + kn + 16 * (q >> 1) + 8 * h + 4 * (q & 1));
                }
                const f32x16 s = kv_scores(cur, qf);
                float pv[16];
#pragma unroll
                for (int q = 0; q < 16; ++q) pv[q] = __builtin_amdgcn_exp2f(fmaf(s[q], c1, ctm - cc[q >> 2][q & 3]));
                if (k0 == q0) {
#pragma unroll
                    for (int q = 0; q < 16; ++q) pv[q] = (kofc(q) <= rdiag) ? pv[q] : 0.f;
                }
                kv_update_fixed(a, pv, vcur);
                cur = nxt; vcur = vnxt;
#pragma unroll
                for (int q = 0; q < 4; ++q) cc[q] = cn[q];
            }
            const float lt = a.l + __shfl_xor(a.l, 32), inv = 1.f / lt;
            bf16_t* dst = p.cat + t * D_ + 512 + hd * 64;
#pragma unroll
            for (int db = 0; db < 2; ++db)
#pragma unroll
                for (int g4 = 0; g4 < 4; ++g4) {
                    u32x2 w; w.x = cvt_pk_bf16(a.o[db][4 * g4] * inv, a.o[db][4 * g4 + 1] * inv); w.y = cvt_pk_bf16(a.o[db][4 * g4 + 2] * inv, a.o[db][4 * g4 + 3] * inv);
                    *(u32x2*)(dst + 32 * db + 8 * g4 + 4 * h) = w;
                }
        }
    }
}

__device__ __forceinline__ void phase_post_odd(const P& p, int layer, char* lds, int wv) {
    const int tid = opaque_tid(wv), lane = tid & 63, wid = __builtin_amdgcn_readfirstlane(tid >> 6), li = layer >> 1, r = lane & 31, h = lane >> 5;
    const int c0 = 8 * lane;
    float qg[8], k1[8], k2[8];
#pragma unroll
    for (int q = 0; q < 8; ++q) { qg[q] = p.o_q_g[li * 64 + ((c0 + q) & 63)]; k1[q] = p.o_k_g[(li * 3 + 1) * 64 + ((c0 + q) & 63)]; k2[q] = p.o_k_g[(li * 3 + 2) * 64 + ((c0 + q) & 63)]; }
    const int gw = blockIdx.x * NWV + wid, nw = gridDim.x * NWV;
    for (int t = gw; t < T_; t += nw) {
        bf16_t* row = p.proj + (size_t)t * ODD_LD;
        headnorm8(row + c0, qg); headnorm8(row + 512 + c0, qg);
        { float kg[8];
#pragma unroll
          for (int q = 0; q < 8; ++q) kg[q] = (lane < 32) ? k1[q] : k2[q];
          const int cg = (lane & 31) * 8;
          headnorm8((lane < 32) ? (row + 1536 + c0) : (row + 2048 + (c0 - 256)), kg,
                    p.kt + (lane < 32 ? (size_t)0 : (size_t)B_ * 4 * 64 * S_) + (size_t)((t >> 11) * 4 + (cg >> 6)) * 64 * S_ + ktile_elem(t & 2047, cg & 63)); }
        if (lane < 48) { const float z = p.fg[(size_t)t * 48 + lane] + p.o_b_gate[li * 48 + lane]; p.gates[(size_t)t * 48 + lane] = 1.f / (1.f + __expf(-z)); }
    }
    for (int grp = gw; grp < T_ / 8; grp += nw) {
        const int t0 = grp * 8, cg = (lane & 31) * 8;
        v_tile8(p.proj + (size_t)t0 * ODD_LD + (lane < 32 ? 1792 : 2304) + cg, ODD_LD,
                p.vT + (lane < 32 ? (size_t)0 : (size_t)B_ * 4 * 64 * S_) + (size_t)((t0 >> 11) * 4 + (cg >> 6)) * 64 * S_, t0 & 2047, cg & 63);
    }
    float* part = (float*)lds;
    for (int u = blockIdx.x; u < 256; u += gridDim.x) {
        const int kv = u >> 7, b = (u >> 4) & 7, g = (u >> 2) & 3, nt = u & 3;
        const int n = nt * 32 + r;
        const bf16_t* w1t = p.w1t + (size_t)(li * 2 + kv) * 64 * 2048;
        const bf16_t* w2t = p.w2t + (size_t)(li * 2 + kv) * 64 * 64;
        const float* c1 = p.c1 + (li * 2 + kv) * 64;
        const int colb = 1024 + kv * 256 + g * 64;
        f32x16 hacc[2];
#pragma unroll
        for (int q = 0; q < 16; ++q) { hacc[0][q] = 0.f; hacc[1][q] = 0.f; }
        for (int l = 4 * wid; l < 4 * wid + 4; ++l) {
            int tok = 16 * n + l; if (tok > 2047) tok = 2047;
            const bf16_t* ar = p.proj + ((size_t)b * S_ + tok) * ODD_LD + colb + 8 * h;
#pragma unroll
            for (int ks = 0; ks < 4; ++ks) {
                const bf16x8 bfrag = ld8(ar + 16 * ks);
#pragma unroll
                for (int ct = 0; ct < 2; ++ct) {
                    const bf16x8 afrag = ld8(w1t + (size_t)(32 * ct + swap23(r)) * 2048 + l * 64 + 16 * ks + 8 * h);
                    hacc[ct] = mfma32(afrag, bfrag, hacc[ct]);
                }
            }
        }
        __syncthreads();
#pragma unroll
        for (int ct = 0; ct < 2; ++ct)
#pragma unroll
            for (int q = 0; q < 16; ++q) part[((wid * 2 + ct) * 16 + q) * 64 + lane] = hacc[ct][q];
        __syncthreads();
        if (wid != 0) continue;
#pragma unroll
        for (int q = 0; q < 16; ++q) { hacc[0][q] = 0.f; hacc[1][q] = 0.f; }
#pragma unroll 1
        for (int w = 0; w < 8; ++w) {
#pragma unroll
            for (int ct = 0; ct < 2; ++ct)
#pragma unroll
                for (int q = 0; q < 16; ++q) hacc[ct][q] += part[((w * 2 + ct) * 16 + q) * 64 + lane];
        }
        union { bf16x8 v; unsigned uu[4]; } hf[2][2];
#pragma unroll
        for (int ct = 0; ct < 2; ++ct)
#pragma unroll
            for (int ks = 0; ks < 2; ++ks)
#pragma unroll
                for (int q = 0; q < 4; ++q) {
                    const int i0 = 8 * ks + 2 * q, cA = 32 * ct + koffs(i0, h), cB = 32 * ct + koffs(i0 + 1, h);
                    hf[ct][ks].uu[q] = cvt_pk_bf16(gelu_tanh(hacc[ct][i0] + c1[cA]), gelu_tanh(hacc[ct][i0 + 1] + c1[cB]));
                }
        f32x16 oacc[2];
#pragma unroll
        for (int q = 0; q < 16; ++q) { oacc[0][q] = 0.f; oacc[1][q] = 0.f; }
#pragma unroll
        for (int et = 0; et < 2; ++et)
#pragma unroll
            for (int ct = 0; ct < 2; ++ct)
#pragma unroll
                for (int ks = 0; ks < 2; ++ks) {
                    const bf16x8 afrag = ld8(w2t + (size_t)(32 * et + r) * 64 + 32 * ct + 16 * ks + 8 * h);
                    oacc[et] = mfma32(afrag, hf[ct][ks].v, oacc[et]);
                }
        if (kv == 0) {
            float ss = 0.f;
#pragma unroll
            for (int q = 0; q < 16; ++q) ss += oacc[0][q] * oacc[0][q] + oacc[1][q] * oacc[1][q];
            ss += __shfl_xor(ss, 32);
            const float rs = rsqrtf(ss * (1.f / 64.f) + 1e-6f);
            bf16_t* dst = p.kc + (size_t)(b * 4 + g) * 128 * 64;
            const float* kg = p.o_k_g + (size_t)(li * 3) * 64;
#pragma unroll
            for (int et = 0; et < 2; ++et)
#pragma unroll
                for (int g4 = 0; g4 < 4; ++g4) {
                    const int e = 32 * et + 8 * g4 + 4 * h;
                    u32x2 w; w.x = cvt_pk_bf16(oacc[et][4 * g4] * rs * kg[e], oacc[et][4 * g4 + 1] * rs * kg[e + 1]); w.y = cvt_pk_bf16(oacc[et][4 * g4 + 2] * rs * kg[e + 2], oacc[et][4 * g4 + 3] * rs * kg[e + 3]);
                    *(u32x2*)(dst + ktile_elem(n, e)) = w;
                }
        } else {
            bf16_t* dst = p.vcT + (size_t)(b * 4 + g) * 64 * 128;
#pragma unroll
            for (int et = 0; et < 2; ++et)
#pragma unroll
                for (int q = 0; q < 16; ++q) dst[vtile_elem(n, 32 * et + rowmap(q, h))] = f_to_bf(oacc[et][q]);
        }
    }
}

__device__ __forceinline__ int rel_bucket_dev(int n) {
    if (n < 16) return n;
    const int thr[15] = {19, 21, 24, 27, 31, 35, 40, 46, 52, 59, 67, 77, 87, 99, 113};
    int bk = 16;
#pragma unroll
    for (int k = 0; k < 15; ++k) bk += (n >= thr[k]) ? 1 : 0;
    return bk;
}
__device__ __forceinline__ void phase_nsa(const P& p, int layer, char* lds, int wv) {
    const int tid = opaque_tid(wv), lane = tid & 63, wid = __builtin_amdgcn_readfirstlane(tid >> 6), li = layer >> 1;
#define NSA_LANE() int lo_ = lane; asm volatile("" : "+v"(lo_)); const int r = lo_ & 31, h = lo_ >> 5; const int tq = q0 + r; const size_t t = (size_t)b * S_ + tq; (void)h; (void)t
    float* lut = (float*)lds;
    float* GS = (float*)(lds + 2048);
    float* LI = (float*)(lds + 2048 + 8 * 2 * 32 * 33 * 4);
    float* myG = GS + wid * 2 * 32 * 33; float* myL = myG + 32 * 33;
    const int j = wid & 3, usel = wid >> 2;
    float kgm = fmaxf(fabsf(p.o_k_g[(li * 3) * 64 + lane]), fmaxf(fabsf(p.o_k_g[(li * 3 + 1) * 64 + lane]), fabsf(p.o_k_g[(li * 3 + 2) * 64 + lane])));
    float tbm = 0.f;
#pragma unroll
    for (int q = 0; q < 8; ++q) tbm = fmaxf(tbm, fabsf(p.rel_table[q * 64 + lane]));
    const float M2 = (8.f * wave_max(fabsf(p.o_q_g[li * 64 + lane])) * wave_max(kgm) + wave_max(tbm)) * LOG2E;
    const float c1 = 0.125f * LOG2E;
    for (int bu = blockIdx.x; bu < 1024; bu += gridDim.x) {
        int bg, pp;
        if (gridDim.x == 256) {
            const int rnd = bu >> 8, xg = blockIdx.x & 7, i = blockIdx.x >> 3, i2 = (i + 16) & 31;
            bg = xg * 4 + rnd; pp = (rnd == 0) ? i : (rnd == 1) ? (31 - i) : (rnd == 2) ? i2 : (31 - i2);
        } else {
            const int rnd = (bu / 256) & 3, k = bu % 256, i8 = k & 7; bg = k >> 3;
            pp = (rnd == 0) ? i8 : (rnd == 1) ? (15 - i8) : (rnd == 2) ? (16 + i8) : (31 - i8);
        }
        const int b = bg >> 2, g = bg & 3;
        __syncthreads();
        { const int jj = tid >> 7, dist = tid & 127; lut[tid] = p.rel_table[rel_bucket_dev(dist) * 16 + g * 4 + jj] * LOG2E - M2; }
        __syncthreads();
        const float* mylut = lut + j * 128; const float b31 = mylut[127];
        const int qt = 2 * pp + usel, q0 = qt * 32;
        const int head = g * 4 + j;
        bf16x8 qf[4];
        unsigned ocp[16];
        unsigned selmask;
        {
        NSA_LANE();
        const int rb = r * 33;
#pragma unroll
        for (int ks = 0; ks < 4; ++ks) qf[ks] = bld8(mk_rsrc(p.proj, (unsigned)((size_t)T_ * ODD_LD * 2)), (unsigned)(t * ODD_LD + head * 64 + 8 * h) * 2u, 32 * ks);
        const rsrc_t rsKc = mk_rsrc(p.kc, (unsigned)(B_ * 4 * 128 * 64 * 2)), rsVc = mk_rsrc(p.vcT, (unsigned)(B_ * 4 * 64 * 128 * 2));
        const unsigned lo16 = (unsigned)lo_ * 16u;
        const unsigned kcb = (unsigned)((b * 4 + g) * 128 * 64 * 2), vcb = kcb;
        const int nkt = (q0 >> 9) + 1;
        AccF ac; accf_init(ac);
#pragma unroll
        for (int m = 0; m < 32; ++m) { if ((m >> 1 & 1) == h) { myG[rb + m] = 0.f; myL[rb + m] = 0.f; } }
#pragma unroll 1
        for (int kt = 0; kt < nkt; ++kt) {
            KF kf_; VF vf_;
            k_load(kf_, rsKc, lo16, kcb + (unsigned)kt * 4096u);
            v_load(vf_, rsVc, lo16, vcb + (unsigned)kt * 4096u);
            const f32x16 s = kv_scores(kf_, qf);
            float pv[16];
            int dbase = tq - 31 - 512 * kt - 128 * h; asm volatile("" : "+v"(dbase));
#pragma unroll
            for (int q = 0; q < 16; ++q) {
                const int dist = dbase - 16 * kofc(q);
                const float e = __builtin_amdgcn_exp2f(fmaf(s[q], c1, mylut[min(max(dist, 0), 127)]));
                pv[q] = (dist >= 0) ? e : 0.f;
            }
            if (kt == 3 && h == 1) pv[15] = 0.f;
#pragma unroll
            for (int gq = 0; gq < 4; ++gq) {
                const int m = 8 * kt + 2 * h + (gq & 1) + 4 * (gq >> 1);
                myG[rb + m] = pv[4 * gq] + pv[4 * gq + 1] + pv[4 * gq + 2] + pv[4 * gq + 3];
                myL[rb + m] = pv[4 * gq + 3];
            }
            kv_update_fixed(ac, pv, vf_);
        }
        const rsrc_t rsG = mk_rsrc(p.gates, (unsigned)((size_t)T_ * 48 * 4)); const unsigned gto = (unsigned)(t * 48 + (g * 4 + j) * 3) * 4u;
        { const float lc = ac.l + __shfl_xor(ac.l, 32); const float linv = (lc > 0.f) ? 1.f / lc : 0.f;
          if (h == 0) LI[wid * 32 + r] = linv;
          const float gc = __uint_as_float(__builtin_amdgcn_raw_buffer_load_b32(rsG, gto, 0, 0)) * linv;
#pragma unroll
          for (int q = 0; q < 8; ++q) { ocp[q] = cvt_pk_bf16(ac.o[0][2 * q] * gc, ac.o[0][2 * q + 1] * gc); ocp[8 + q] = cvt_pk_bf16(ac.o[1][2 * q] * gc, ac.o[1][2 * q + 1] * gc); } }
        }
        __syncthreads();
        {
        NSA_LANE();
        const int rb = r * 33;
            const float* G0 = GS + (usel * 4) * 2 * 32 * 33;
            float li4[4];
#pragma unroll
            for (int jj = 0; jj < 4; ++jj) li4[jj] = LI[(usel * 4 + jj) * 32 + r];
            float imp[32];
            const int cur = tq >> 6;
#pragma unroll
            for (int m = 0; m < 32; ++m) {
                float v = 0.f;
#pragma unroll
                for (int jj = 0; jj < 4; ++jj) { const float* Gj = G0 + jj * 2 * 32 * 33; float gl = Gj[rb + m]; if (m > 0) gl += Gj[32 * 33 + rb + m - 1]; v += li4[jj] * gl; }
                v = (m == 0 || m == cur || m == cur - 1) ? 1e6f : ((m <= cur) ? v : -1.f);
                imp[m] = __uint_as_float((__float_as_uint(v) & ~31u) | (unsigned)(31 - m));
            }
            unsigned mym = 0;
            const unsigned hm = (unsigned)(-h);
#pragma unroll
            for (int mi = 0; mi < 16; ++mi) {
                const float mine = __uint_as_float((__float_as_uint(imp[mi]) & ~hm) | (__float_as_uint(imp[16 + mi]) & hm));
                int rank = 0;
#pragma unroll
                for (int m2 = 0; m2 < 32; ++m2) rank += (imp[m2] > mine) ? 1 : 0;
                unsigned bit = (rank < 16 && mine >= 0.f) ? 1u : 0u; asm volatile("" : "+v"(bit));
                mym |= bit << mi;
            }
            mym <<= 16 * h;
            selmask = mym | (unsigned)__shfl_xor((int)mym, 32);
        }
        const rsrc_t rsK = mk_rsrc(p.kt, (unsigned)((size_t)T_ * 512 * 2)), rsV = mk_rsrc(p.vT, (unsigned)((size_t)T_ * 512 * 2));
        const unsigned ksb = (unsigned)((size_t)(b * 4 + g) * 64 * S_ * 2), vsb = ksb;
        {
        NSA_LANE();
        const unsigned lo16 = (unsigned)lo_ * 16u;
        const rsrc_t rsG = mk_rsrc(p.gates, (unsigned)((size_t)T_ * 48 * 4)); const unsigned gto = (unsigned)(t * 48 + (g * 4 + j) * 3) * 4u;
        AccF as; accf_init(as);
        {
            unsigned long long vis;
            { unsigned long long x = (unsigned long long)wave_or(selmask);
              x = (x | (x << 16)) & 0x0000FFFF0000FFFFull; x = (x | (x << 8)) & 0x00FF00FF00FF00FFull; x = (x | (x << 4)) & 0x0F0F0F0F0F0F0F0Full;
              x = (x | (x << 2)) & 0x3333333333333333ull; x = (x | (x << 1)) & 0x5555555555555555ull; vis = x | (x << 1);
              if (qt < 63) vis &= ((1ull << (qt + 1)) - 1ull); }
            KF cur, nxt; VF vcur;
            int tile = __builtin_ctzll(vis); vis &= vis - 1ull;
            k_load(cur, rsK, lo16, ksb + (unsigned)tile * 4096u);
#pragma unroll 1
            for (;;) {
                const bool more = vis != 0ull; int ntile = 0;
                v_load(vcur, rsV, lo16, vsb + (unsigned)tile * 4096u);
                ntile = more ? (int)__builtin_ctzll(vis) : tile; vis &= vis - 1ull;
                k_load(nxt, rsK, lo16, ksb + (unsigned)ntile * 4096u);
                const int k0 = tile * 32;
                const f32x16 s = kv_scores(cur, qf);
                const bool on = (selmask >> (tile >> 1)) & 1u;
                float pv[16];
                if (q0 - (k0 + 31) >= 113) {
                    const float bb = on ? b31 : -1e30f;
#pragma unroll
                    for (int q = 0; q < 16; ++q) pv[q] = __builtin_amdgcn_exp2f(fmaf(s[q], c1, bb));
                } else {
                    int dbase = tq - k0 - 8 * h; asm volatile("" : "+v"(dbase));
#pragma unroll
                    for (int q = 0; q < 16; ++q) {
                        const int dist = dbase - kofc(q);
                        const float e = __builtin_amdgcn_exp2f(fmaf(s[q], c1, mylut[min(max(dist, 0), 127)]));
                        pv[q] = (on && dist >= 0) ? e : 0.f;
                    }
                }
                kv_update_fixed(as, pv, vcur);
                if (!more) break;
                cur = nxt; tile = ntile;
            }
        }
        { const float ls = as.l + __shfl_xor(as.l, 32); const float gs = __uint_as_float(__builtin_amdgcn_raw_buffer_load_b32(rsG, gto, 4, 0)) / ls;
#pragma unroll
          for (int q = 0; q < 8; ++q) { ocp[q] = cvt_pk_bf16(bf_lo(ocp[q]) + gs * as.o[0][2 * q], bf_hi(ocp[q]) + gs * as.o[0][2 * q + 1]); ocp[8 + q] = cvt_pk_bf16(bf_lo(ocp[8 + q]) + gs * as.o[1][2 * q], bf_hi(ocp[8 + q]) + gs * as.o[1][2 * q + 1]); } }
        }
        {
        NSA_LANE();
        const unsigned lo16 = (unsigned)lo_ * 16u;
        const rsrc_t rsG = mk_rsrc(p.gates, (unsigned)((size_t)T_ * 48 * 4)); const unsigned gto = (unsigned)(t * 48 + (g * 4 + j) * 3) * 4u;
        const unsigned kwb = (unsigned)(((size_t)B_ * 4 * 64 * S_ + (size_t)(b * 4 + g) * 64 * S_) * 2), vwb = kwb;
        AccF aw; accf_init(aw);
        {
            KF cur, nxt; VF vcur;
            const int kstart = (q0 >= 512 ? q0 - 512 : 0);
            k_load(cur, rsK, lo16, kwb + (unsigned)kstart * 128u);
#pragma unroll 1
            for (int k0 = kstart; k0 <= q0; k0 += 32) {
                v_load(vcur, rsV, lo16, vwb + (unsigned)k0 * 128u);
                k_load(nxt, rsK, lo16, kwb + (unsigned)((k0 + 32 <= q0) ? k0 + 32 : k0) * 128u);
                const f32x16 s = kv_scores(cur, qf);
                float pv[16];
                if (q0 - (k0 + 31) >= 113 && q0 + 31 - k0 < 512) {
#pragma unroll
                    for (int q = 0; q < 16; ++q) pv[q] = __builtin_amdgcn_exp2f(fmaf(s[q], c1, b31));
                } else {
                    int dbase = tq - k0 - 8 * h; asm volatile("" : "+v"(dbase));
#pragma unroll
                    for (int q = 0; q < 16; ++q) {
                        const int dist = dbase - kofc(q);
                        const float e = __builtin_amdgcn_exp2f(fmaf(s[q], c1, mylut[min(max(dist, 0), 127)]));
                        pv[q] = (dist >= 0 && dist < 512) ? e : 0.f;
                    }
                }
                kv_update_fixed(aw, pv, vcur);
                cur = nxt;
            }
        }
        const float lw = aw.l + __shfl_xor(aw.l, 32);
        const float gwv = __uint_as_float(__builtin_amdgcn_raw_buffer_load_b32(rsG, gto, 8, 0)) / lw;
        const rsrc_t rsC = mk_rsrc(p.cat, (unsigned)((size_t)T_ * D_ * 2)); const unsigned dsto = (unsigned)(t * D_ + head * 64) * 2u;
#pragma unroll
        for (int db = 0; db < 2; ++db)
#pragma unroll
            for (int g4 = 0; g4 < 4; ++g4) {
                float o[4];
#pragma unroll
                for (int q = 0; q < 4; ++q) { const unsigned pw = ocp[8 * db + 2 * g4 + (q >> 1)]; o[q] = ((q & 1) ? bf_hi(pw) : bf_lo(pw)) + gwv * aw.o[db][4 * g4 + q]; }
                u32x2 w; w.x = cvt_pk_bf16(o[0], o[1]); w.y = cvt_pk_bf16(o[2], o[3]);
                __builtin_amdgcn_raw_buffer_store_b64(w, rsC, dsto + (unsigned)(32 * db + 8 * g4 + 4 * h) * 2u, 0, 0);
            }
        }
    }
#undef NSA_LANE
}

#define SN_HD __device__ __forceinline__
template <int N> SN_HD void sn_sort_desc(float (&v)[N]) {
#pragma unroll
    for (int k = 2; k <= N; k <<= 1)
#pragma unroll
        for (int j = k >> 1; j > 0; j >>= 1)
#pragma unroll
            for (int i = 0; i < N; ++i) { const int l = i ^ j; if (l > i) { const bool desc = ((i & k) == 0); const float a = v[i], b = v[l], hi = fmaxf(a, b), lo = fminf(a, b); v[i] = desc ? hi : lo; v[l] = desc ? lo : hi; } }
}
template <int N> SN_HD void sn_merge_desc(float (&v)[N]) {
#pragma unroll
    for (int j = N >> 1; j > 0; j >>= 1)
#pragma unroll
        for (int i = 0; i < N; ++i) if ((i & j) == 0) { const float a = v[i], b = v[i + j]; v[i] = fmaxf(a, b); v[i + j] = fminf(a, b); }
}
SN_HD void sn_top16_merge(float (&x)[16], const float (&y)[16]) {
#pragma unroll
    for (int i = 0; i < 16; ++i) x[i] = fmaxf(x[i], y[15 - i]);
    sn_merge_desc<16>(x);
}
SN_HD void sn_top16_of64(float (&v)[64], float (&out)[16]) {
    float g[4][16];
#pragma unroll
    for (int q = 0; q < 4; ++q) {
#pragma unroll
        for (int i = 0; i < 16; ++i) g[q][i] = v[16 * q + i];
        sn_sort_desc<16>(g[q]);
    }
    sn_top16_merge(g[0], g[1]); sn_top16_merge(g[2], g[3]); sn_top16_merge(g[0], g[2]);
#pragma unroll
    for (int i = 0; i < 16; ++i) out[i] = g[0][i];
}

__device__ __forceinline__ float sel_h(float a, float b, unsigned hm) { return __uint_as_float((__float_as_uint(a) & ~hm) | (__float_as_uint(b) & hm)); }
__device__ __forceinline__ void phase_peer_sel(const P& p, int layer, char* lds, int wv) {
    const int tid = opaque_tid(wv), lane = tid & 63, wid = __builtin_amdgcn_readfirstlane(tid >> 6), r = lane & 31, h = lane >> 5;
    const unsigned hm = (unsigned)(-h);
    constexpr int CI[50] = {0, 0, 0, 0, 0, 0, 0, 0, 0, 0, 0, 0, 0, 0, 0, 0, 1, 1, 1, 1, 1, 1, 1, 1, 2, 2, 2, 2, 2, 3, 3, 3, 3, 4, 4, 4, 5, 5, 6, 6, 7, 7, 8, 9, 10, 11, 12, 13, 14, 15};
    constexpr int CJ[50] = {0, 1, 2, 3, 4, 5, 6, 7, 8, 9, 10, 11, 12, 13, 14, 15, 0, 1, 2, 3, 4, 5, 6, 7, 0, 1, 2, 3, 4, 0, 1, 2, 3, 0, 1, 2, 0, 1, 0, 1, 0, 1, 0, 0, 0, 0, 0, 0, 0, 0};
    unsigned char* ixl = (unsigned char*)lds + 36864 + wid * 1024 + r * 32;
    __syncthreads();
    for (int i = tid; i < 256 * 8; i += NTHR) { const int row = i >> 3, ch = i & 7; *(u32x4*)(lds + row * 144 + ch * 16) = *(const u32x4*)(p.keys16 + (size_t)layer * 2 * 128 * 64 + row * 64 + ch * 8); }
    __syncthreads();
    const bf16_t* Q16 = (const bf16_t*)p.qp;
    const int nw = gridDim.x * NWV;
    for (int task = blockIdx.x * NWV + wid; task < T_ * 8 / 32; task += nw) {
        const int t = task * 4 + (r >> 3), hd = r & 7;
        int kro = r * 144 + 16 * h; asm volatile("" : "+v"(kro));
        float top[2][16];
#pragma unroll
        for (int pp = 0; pp < 2; ++pp) {
            const bf16_t* qrow = Q16 + (size_t)t * D_ + hd * 128 + pp * 64 + 8 * h;
            bf16x8 qf[4];
#pragma unroll
            for (int ks = 0; ks < 4; ++ks) qf[ks] = ld8(qrow + 16 * ks);
            float z[16], o[16];
#pragma unroll
            for (int kt = 0; kt < 4; ++kt) {
                f32x16 s;
#pragma unroll
                for (int q = 0; q < 16; ++q) s[q] = 0.f;
#pragma unroll
                for (int ks = 0; ks < 4; ++ks) s = mfma32(*(const bf16x8*)(lds + kro + (pp * 128 + 32 * kt) * 144 + 32 * ks), qf[ks], s);
#pragma unroll
                for (int q = 0; q < 16; ++q) o[q] = __uint_as_float((__float_as_uint(s[q]) & ~127u) | (unsigned)(32 * kt + rowmap(q, h)));
                sn_sort_desc<16>(o);
                if (kt == 0) {
#pragma unroll
                    for (int i = 0; i < 16; ++i) z[i] = o[i];
                } else sn_top16_merge(z, o);
                __builtin_amdgcn_sched_barrier(0);
            }
#pragma unroll
            for (int i = 0; i < 16; ++i) o[i] = __shfl_xor(z[i], 32);
            sn_top16_merge(z, o);
#pragma unroll
            for (int i = 0; i < 16; ++i) top[pp][i] = z[i];
            __builtin_amdgcn_sched_barrier(0);
        }
        {
            unsigned w[4];
#pragma unroll
            for (int q = 0; q < 4; ++q) {
                unsigned acc = 0;
#pragma unroll
                for (int b4 = 0; b4 < 4; ++b4) acc |= (__float_as_uint(sel_h(top[0][4 * q + b4], top[1][4 * q + b4], hm)) & 127u) << (8 * b4);
                w[q] = acc;
            }
            *(u32x4*)(ixl + 16 * h) = (u32x4){w[0], w[1], w[2], w[3]};
        }
        float c[32];
#pragma unroll
        for (int k = 0; k < 25; ++k) {
            const float s0 = top[0][CI[k]] + top[1][CJ[k]], s1 = top[0][CI[25 + k]] + top[1][CJ[25 + k]];
            const unsigned code = h ? (unsigned)((CI[25 + k] << 4) | CJ[25 + k]) : (unsigned)((CI[k] << 4) | CJ[k]);
            c[k] = __uint_as_float((__float_as_uint(sel_h(s0, s1, hm)) & ~255u) | code);
        }
#pragma unroll
        for (int k = 25; k < 32; ++k) c[k] = -INFINITY;
        float fa[16], fb[16];
#pragma unroll
        for (int i = 0; i < 16; ++i) { fa[i] = c[i]; fb[i] = c[16 + i]; }
        __builtin_amdgcn_sched_barrier(0);
        sn_sort_desc<16>(fa); __builtin_amdgcn_sched_barrier(0); sn_sort_desc<16>(fb); __builtin_amdgcn_sched_barrier(0); sn_top16_merge(fa, fb);
#pragma unroll
        for (int i = 0; i < 16; ++i) fb[i] = __shfl_xor(fa[i], 32);
        sn_top16_merge(fa, fb);
        float den = 0.f, ex[16];
#pragma unroll
        for (int i = 0; i < 16; ++i) { ex[i] = __expf(fa[i] - fa[0]); den += ex[i]; }
        const float rden = 1.f / den;
        __builtin_amdgcn_wave_barrier();
        int eo[8]; float go[8];
#pragma unroll
        for (int kk = 0; kk < 8; ++kk) {
            const unsigned code = __float_as_uint(sel_h(fa[kk], fa[8 + kk], hm)) & 255u;
            const unsigned ia = ixl[code >> 4], ib = ixl[16 + (code & 15u)];
            eo[kk] = (int)(ia * 128u + ib); go[kk] = sel_h(ex[kk], ex[8 + kk], hm) * rden;
        }
        const size_t ob = ((size_t)t * 8 + hd) * 16 + 8 * h;
        *(u32x4*)(p.seli + ob) = (u32x4){(unsigned)eo[0], (unsigned)eo[1], (unsigned)eo[2], (unsigned)eo[3]}; *(u32x4*)(p.seli + ob + 4) = (u32x4){(unsigned)eo[4], (unsigned)eo[5], (unsigned)eo[6], (unsigned)eo[7]};
        *(f32x4*)(p.selg + ob) = (f32x4){go[0], go[1], go[2], go[3]}; *(f32x4*)(p.selg + ob + 4) = (f32x4){go[4], go[5], go[6], go[7]};
        __builtin_amdgcn_wave_barrier();
    }
}

__device__ __forceinline__ float dpp_xor1(float v) { return DPPF(v, v, 0xB1, 0xf); }
template <int I, int N, class F> __device__ __forceinline__ void static_for(F&& f) { if constexpr (I < N) { f(std::integral_constant<int, I>{}); static_for<I + 1, N>(f); } }
template <int I> __device__ __forceinline__ int row_bcast(int x) { return __builtin_amdgcn_update_dpp(0, x, 0x150 + I, 0xf, 0xf, true); }
struct PaRaw { int i0, i1; float g0, g1; u32x3 h0, h1; };
__device__ __forceinline__ u32x3 pack6x16(u32x4 b) {
    unsigned c[16];
#pragma unroll
    for (int q = 0; q < 4; ++q) { c[4 * q] = b[q] & 63u; c[4 * q + 1] = (b[q] >> 8) & 63u; c[4 * q + 2] = (b[q] >> 16) & 63u; c[4 * q + 3] = (b[q] >> 24) & 63u; }
    u32x3 d;
    d.x = c[0] | (c[1] << 6) | (c[2] << 12) | (c[3] << 18) | (c[4] << 24) | (c[5] << 30);
    d.y = (c[5] >> 2) | (c[6] << 4) | (c[7] << 10) | (c[8] << 16) | (c[9] << 22) | (c[10] << 28);
    d.z = (c[10] >> 4) | (c[11] << 2) | (c[12] << 8) | (c[13] << 14) | (c[14] << 20) | (c[15] << 26);
    return d;
}
__device__ __forceinline__ long lo64(u32x4 v) { return (long)(((unsigned long)v.y << 32) | v.x); }
__device__ __forceinline__ long hi64(u32x4 v) { return (long)(((unsigned long)v.w << 32) | v.z); }
__device__ __forceinline__ float dpp_xor2(float v) { return DPPF(v, v, 0x4E, 0xf); }
template <int GH = 0>
__device__ __forceinline__ void phase_peer_a(const P& p, int layer, char* lds, int wv) {
    const int tid = opaque_tid(wv), lane = tid & 63, wid = __builtin_amdgcn_readfirstlane(tid >> 6);
    const int wig = blockIdx.x * NWV + wid, nwg = gridDim.x * NWV;
    if (wig >= T_) return;
    const rsrc_t rsU = mk_rsrc(p.u8 + (size_t)layer * 16384 * 768, 16384u * 768u);
    const rsrc_t rsI = mk_rsrc(p.seli, (unsigned)((size_t)T_ * 128 * 4)), rsG = mk_rsrc(p.selg, (unsigned)((size_t)T_ * 128 * 4));
    const rsrc_t rsH = mk_rsrc(p.h8, (unsigned)((size_t)T_ * 1536)), rsS = mk_rsrc(p.hinv, (unsigned)((size_t)T_ * 4));
    unsigned short* wq = GH ? (unsigned short*)p.proj : (unsigned short*)p.wexp; float* winv = GH ? (float*)p.proj + (size_t)T_ * 64 : p.winv;
    const unsigned lo16 = (unsigned)lane * 16u;
    const int ntok = (T_ - 1 - wig) / nwg + 1;
    auto tok_at = [&](int k) { return wig + ((k < ntok) ? k : 0) * nwg; };
    auto raw_load = [&](PaRaw& r, int t) {
        r.i0 = (int)__builtin_amdgcn_raw_buffer_load_b32(rsI, (unsigned)lane * 4u, (unsigned)__builtin_amdgcn_readfirstlane(t * 512), 0);
        r.i1 = (int)__builtin_amdgcn_raw_buffer_load_b32(rsI, (unsigned)lane * 4u, (unsigned)__builtin_amdgcn_readfirstlane(t * 512 + 256), 0);
        r.g0 = __uint_as_float(__builtin_amdgcn_raw_buffer_load_b32(rsG, (unsigned)lane * 4u, (unsigned)__builtin_amdgcn_readfirstlane(t * 512), 0));
        r.g1 = __uint_as_float(__builtin_amdgcn_raw_buffer_load_b32(rsG, (unsigned)lane * 4u, (unsigned)__builtin_amdgcn_readfirstlane(t * 512 + 256), 0));
        r.h0 = __builtin_amdgcn_raw_buffer_load_b96(rsH, (unsigned)lane * 24u, (unsigned)__builtin_amdgcn_readfirstlane(t * 1536), 0);
        r.h1 = __builtin_amdgcn_raw_buffer_load_b96(rsH, (unsigned)lane * 24u + 12u, (unsigned)__builtin_amdgcn_readfirstlane(t * 1536), 0); };
    const bool ond = ((lane & 15) >> 2) == (lane >> 4);
    const float dw0 = (ond && (lane & 3) == 0) ? 1.f : 0.f, dw1 = (ond && (lane & 3) == 1) ? 1.f : 0.f, dw2 = (ond && (lane & 3) == 2) ? 1.f : 0.f, dw3 = (ond && (lane & 3) == 3) ? 1.f : 0.f;
    const bool b0 = lane & 1, b1 = lane & 2, b2 = lane & 4;
    u32x3 buf[4][8]; const unsigned lo12 = (unsigned)lane * 12u;
    constexpr int LA = 2;
    PaRaw RC, RN;
    raw_load(RC, tok_at(0));
    static_for<0, LA>([&](auto sc_) { constexpr int q = decltype(sc_)::value;
#pragma unroll
        for (int e = 0; e < 8; ++e) { int ex = rdlanei(q < 8 ? RC.i0 : RC.i1, (8 * q + e) & 63); if (GH) ex &= 255; buf[q][e] = __builtin_amdgcn_raw_buffer_load_b96(rsU, lo12, (unsigned)ex * 768u, 0); } });
#pragma unroll 1
    for (int kt = 0; kt < ntok; ++kt) {
        const int t = wig + kt * nwg;
        raw_load(RN, tok_at(kt + 1));
        const float hinv = __uint_as_float(__builtin_amdgcn_raw_buffer_load_b32(rsS, 0u, (unsigned)__builtin_amdgcn_readfirstlane(t * 4), 0));
        const float inv = hinv * (1.f / U6_SCALE);
        float R = 0.f, W0 = 0.f;
        const v8i32 hB = {(int)RC.h0.x, (int)RC.h0.y, (int)RC.h0.z, (int)RC.h1.x, (int)RC.h1.y, (int)RC.h1.z, 0, 0};
        static_for<0, 16>([&](auto sc_) { constexpr int s = decltype(sc_)::value;
            {
                constexpr int q = (s + LA) & 15; constexpr bool nx = (s + LA) >= 16;
#pragma unroll
                for (int e = 0; e < 8; ++e) { int ex = rdlanei(nx ? (q < 8 ? RN.i0 : RN.i1) : (q < 8 ? RC.i0 : RC.i1), (8 * q + e) & 63); if (GH) ex &= 255;
                    buf[(s + LA) & 3][e] = __builtin_amdgcn_raw_buffer_load_b96(rsU, lo12, (unsigned)ex * 768u, 0); }
            }
            float d[8]; f32x4 acc[8];
#pragma unroll
            for (int e = 0; e < 8; ++e) {
                const u32x3 r = buf[s & 3][e];
                const v8i32 A = {(int)r.x, (int)r.y, (int)r.z, (int)r.x, (int)r.y, (int)r.z, 0, 0};
                acc[e] = __builtin_amdgcn_mfma_scale_f32_16x16x128_f8f6f4(A, hB, (f32x4){0.f, 0.f, 0.f, 0.f}, 2, 2, 0, 0x7f7f7f7f, 0, 0x7f7f7f7f);
            }
#pragma unroll
            for (int e = 0; e < 8; ++e) d[e] = acc[e][0] * dw0 + acc[e][1] * dw1 + acc[e][2] * dw2 + acc[e][3] * dw3;
            float n1[4], n2[2];
#pragma unroll
            for (int i = 0; i < 4; ++i) { const float a = b0 ? d[2 * i + 1] : d[2 * i], b = b0 ? d[2 * i] : d[2 * i + 1]; n1[i] = a + dpp_xor1(b); }
#pragma unroll
            for (int i = 0; i < 2; ++i) { const float a = b1 ? n1[2 * i + 1] : n1[2 * i], b = b1 ? n1[2 * i] : n1[2 * i + 1]; n2[i] = a + dpp_xor2(b); }
            float sm; { const float a = b2 ? n2[1] : n2[0], b = b2 ? n2[0] : n2[1]; sm = a + __int_as_float(__builtin_amdgcn_ds_swizzle(__float_as_int(b), 0x101f)); }
            sm += DPPF(sm, sm, 0x128, 0xf);
            sm += __shfl_xor(sm, 16); sm += __shfl_xor(sm, 32);
            R = ((lane >> 3) == (s & 7)) ? sm : R;
            if constexpr (s == 7) W0 = RC.g0 * gelu_tanh(R * inv);
            if constexpr (s == 15) {
                const float W1 = RC.g1 * gelu_tanh(R * inv);
                const float am = wave_max(fmaxf(fmaxf(fabsf(W0), fabsf(W1)), 1e-30f)), sc = 7.5f / am;
                const float q0 = W0 * sc, q1 = W1 * sc;
                const unsigned h0c = enc_e2m3(q0), h1c = enc_e2m3(q1), l0c = enc_e2m3(q0 - dec_e2m3(h0c)), l1c = enc_e2m3(q1 - dec_e2m3(h1c));
                wq[(size_t)t * 128 + lane] = (unsigned short)(h0c | (l0c << 8));
                wq[(size_t)t * 128 + 64 + lane] = (unsigned short)(h1c | (l1c << 8));
                if (lane == 0) winv[t] = am * (1.f / 7.5f);
            }
        });
        RC = RN;
    }
}
#ifndef PB6_TERMS
#define PB6_TERMS 1
#endif
template <int GH = 0>
__device__ __forceinline__ void phase_peer_b6(const P& p, int layer, int wv) {
    const int tid = opaque_tid(wv), lane = tid & 63, wid = __builtin_amdgcn_readfirstlane(tid >> 6);
    constexpr int CSB = 192, NPS = 4, NCLS = 2;
    const int wig = (blockIdx.x >> 3) * NWV + wid, nwg = (gridDim.x >> 3) * NWV;
    const int mm = lane & 15, kbb = lane >> 4, ps = kbb;
    const unsigned widC = (mm <= 10) ? 6u : 0u, s64 = (mm <= 10) ? 6u * (unsigned)mm : 0u;
    const unsigned off2 = (mm == 10) ? 4u : 0u, wid2 = (mm == 10) ? 2u : (mm >= 11 ? 6u : 0u), sA2 = (mm >= 11) ? 6u * (unsigned)mm - 64u : 0u;
    auto sel6 = [&](unsigned w, bool second, int& d0, int& d1, int& d2) {
        const unsigned long long x = (unsigned long long)__builtin_amdgcn_ubfe(w, second ? 8u : 0u, widC) << s64;
        d0 = (int)(unsigned)x; d1 = (int)(unsigned)(x >> 32); d2 = (int)(__builtin_amdgcn_ubfe(w, second ? off2 + 8u : off2, wid2) << sA2); };
    {
        const int xgp = (int)(blockIdx.x & 7), xs = xgp % 4, th = xgp / 4;
        const rsrc_t rsI = mk_rsrc(p.seli, (unsigned)((size_t)T_ * 128 * 4)), rsW = mk_rsrc(p.wexp, (unsigned)((size_t)T_ * 128 * 2)), rsS = mk_rsrc(p.winv, (unsigned)((size_t)T_ * 4));
        const rsrc_t rsVs = mk_rsrc(p.v8 + ((size_t)layer * 4 + xs) * 16384 * CSB, 16384u * (unsigned)CSB);
        const unsigned cco = (unsigned)mm * 12u;
        const int ntok = (T_ / NCLS - 1 - wig) / nwg + 1;
        if (wig >= T_ / NCLS) return;
        u32x3 va[16], vb[16]; f32x4 acc;
        struct BRaw { int i0, i1, w0, w1; float sv; };
        auto tok_at = [&](int k) { const int kk = (k < ntok) ? k : 0; return NCLS * (wig + kk * nwg) + th; };
        auto raw_load = [&](BRaw& r, int t) { r.i0 = (int)__builtin_amdgcn_raw_buffer_load_b32(rsI, (unsigned)lane * 4u, (unsigned)__builtin_amdgcn_readfirstlane(t * 512), 0);
            r.i1 = (int)__builtin_amdgcn_raw_buffer_load_b32(rsI, (unsigned)lane * 4u, (unsigned)__builtin_amdgcn_readfirstlane(t * 512 + 256), 0);
            r.w0 = (int)(unsigned short)__builtin_amdgcn_raw_buffer_load_b16(rsW, (unsigned)lane * 2u, (unsigned)__builtin_amdgcn_readfirstlane(t * 256), 0);
            r.w1 = (int)(unsigned short)__builtin_amdgcn_raw_buffer_load_b16(rsW, (unsigned)lane * 2u, (unsigned)__builtin_amdgcn_readfirstlane(t * 256 + 128), 0);
            r.sv = __uint_as_float(__builtin_amdgcn_raw_buffer_load_b32(rsS, 0u, (unsigned)__builtin_amdgcn_readfirstlane(t * 4), 0)); };
#define PB6_PREP(E_, W_, r_, bb) { const int sl_ = 4 * mm + ps; const int a_ = __shfl((bb) ? r_.i1 : r_.i0, sl_); E_ = (GH ? (a_ & 255) : a_) * CSB; W_ = __shfl((bb) ? r_.w1 : r_.w0, sl_); }
#define PB6_GATHER(v_, E_) static_for<0, 16>([&](auto ic_) { constexpr int i = decltype(ic_)::value; v_[i] = __builtin_amdgcn_raw_buffer_load_b96(rsVs, (unsigned)row_bcast<i>(E_) + cco, 0, 0); })
#define PB6_ACC(v_, W_) static_for<0, 8>([&](auto ic_) { constexpr int i = 2 * decltype(ic_)::value; const unsigned wa_ = (unsigned)row_bcast<i>(W_), wb_ = (unsigned)row_bcast<i + 1>(W_); \
            const v8i32 bv_ = {(int)v_[i].x, (int)v_[i].y, (int)v_[i].z, (int)v_[i + 1].x, (int)v_[i + 1].y, (int)v_[i + 1].z, 0, 0}; \
            { int h0_, h1_, h2_, h3_, h4_, h5_; sel6(wa_, false, h0_, h1_, h2_); sel6(wb_, false, h3_, h4_, h5_); const v8i32 ah_ = {h0_, h1_, h2_, h3_, h4_, h5_, 0, 0}; \
              acc = __builtin_amdgcn_mfma_scale_f32_16x16x128_f8f6f4(ah_, bv_, acc, 2, 2, 0, 0x7f7f7f7f, 0, 0x7f7f7f7f); } \
            if (PB6_TERMS == 2) { int l0_, l1_, l2_, l3_, l4_, l5_; sel6(wa_, true, l0_, l1_, l2_); sel6(wb_, true, l3_, l4_, l5_); const v8i32 al_ = {l0_, l1_, l2_, l3_, l4_, l5_, 0, 0}; \
              acc = __builtin_amdgcn_mfma_scale_f32_16x16x128_f8f6f4(al_, bv_, acc, 2, 2, 0, 0x7f7f7f7f, 0, 0x7f7f7f7f); } })
        BRaw RC, RN;
        raw_load(RC, tok_at(0)); raw_load(RN, tok_at(1));
        int Ea, Eb, Wa, Wb;
        PB6_PREP(Ea, Wa, RC, 0); PB6_GATHER(va, Ea);
        const int cL = 16 * mm + 4 * kbb;
        const rsrc_t rsO = mk_rsrc(GH ? (const void*)p.proj : (const void*)p.out, (unsigned)((size_t)T_ * D_ * 4)), rsM = mk_rsrc(p.mods, (unsigned)((size_t)4 * B_ * 6144 * 4));
        const unsigned cvo = (unsigned)(256 * xs + cL) * 4u;
#pragma unroll 1
        for (int kt = 0; kt < ntok; ++kt) {
            const int t = NCLS * (wig + kt * nwg) + th;
            const unsigned xoff = (unsigned)__builtin_amdgcn_readfirstlane(t * (D_ * 4)), goff = (unsigned)__builtin_amdgcn_readfirstlane(((layer * B_ + (t >> 11)) * 6144 + 5120) * 4);
            const f32x4 xa = __builtin_bit_cast(f32x4, __builtin_amdgcn_raw_buffer_load_b128(rsO, cvo, xoff, 0));
            const f32x4 ga = __builtin_bit_cast(f32x4, __builtin_amdgcn_raw_buffer_load_b128(rsM, cvo, goff, 0));
            acc = (f32x4){0.f, 0.f, 0.f, 0.f};
            PB6_PREP(Eb, Wb, RC, 1); PB6_GATHER(vb, Eb); PB6_ACC(va, Wa);
            PB6_PREP(Ea, Wa, RN, 0); PB6_GATHER(va, Ea);
            PB6_ACC(vb, Wb);
            const float ws = RC.sv * (1.f / V6_SCALE);
            RC = RN; raw_load(RN, tok_at(kt + 2));
            f32x4 oa;
#pragma unroll
            for (int q = 0; q < 4; ++q) oa[q] = xa[q] + ga[q] * (acc[q] * ws);
            __builtin_amdgcn_raw_buffer_store_b128(__builtin_bit_cast(u32x4, oa), rsO, cvo, xoff, 0);
        }
#undef PB6_PREP
#undef PB6_GATHER
#undef PB6_ACC
    }
}

#define XB_TMO      128
#define XB_XCNT(j)  (256  + 64 * (j))
#define XB_XSUB(j)  (1280 + 64 * (j))
#define XB_XGEN(j)  (2304 + 64 * (j))
#define XB_TOP      3328
#define XB_TOPGEN   3392
#define XCD_BAR_WORDS 3456
#define XB_SPIN_CAP (1u << 18)
#define LAS __attribute__((address_space(3)))

__device__ __forceinline__ unsigned xb_ld(unsigned* p)              { return __hip_atomic_load(p, __ATOMIC_RELAXED, __HIP_MEMORY_SCOPE_AGENT); }
__device__ __forceinline__ unsigned xb_add(unsigned* p, unsigned v) { return __hip_atomic_fetch_add(p, v, __ATOMIC_RELAXED, __HIP_MEMORY_SCOPE_AGENT); }
__device__ __forceinline__ unsigned xb_xcc_id() { return (unsigned)__builtin_amdgcn_s_getreg((3 << 11) | 20) & 0xFu; }
#define XB_SPIN(cond, bar) do { unsigned _sp = 0; while (cond) { __builtin_amdgcn_s_sleep(1); \
    if ((++_sp & 255u) == 0u) { if (xb_ld(&(bar)[XB_TMO])) break; if (_sp > XB_SPIN_CAP) { atomicAdd(&(bar)[XB_TMO], 1u); break; } } } } while (0)

struct XcdBarrier {
    unsigned* bar; unsigned x;
    volatile LAS unsigned* st;
};

__device__ __forceinline__ XcdBarrier xcd_barrier_post(unsigned* bar, volatile LAS unsigned* st) {
    XcdBarrier b; b.bar = bar; b.x = xb_xcc_id(); b.st = st;
    if (threadIdx.x == 0) (void)xb_add(&bar[XB_XCNT(b.x)], 1u);
    return b;
}
__device__ __forceinline__ void xcd_barrier_complete(unsigned* bar, unsigned x, unsigned& nloc, unsigned& nx) {
    const unsigned G = gridDim.x * gridDim.y * gridDim.z;
    unsigned sum, cnt, mine, sp = 0u;
    for (;;) {
        sum = 0u; cnt = 0u; mine = 0u;
#pragma unroll
        for (unsigned j = 0; j < 16; ++j) { const unsigned c = xb_ld(&bar[XB_XCNT(j)]); sum += c; cnt += (c > 0u) ? 1u : 0u; mine = (j == x) ? c : mine; }
        if (sum == G) break;
        __builtin_amdgcn_s_sleep(1);
        if ((++sp & 255u) == 0u) { if (xb_ld(&bar[XB_TMO])) break; if (sp > XB_SPIN_CAP) { atomicAdd(&bar[XB_TMO], 1u); break; } }
    }
    nloc = mine > 0u ? mine : 1u; nx = cnt > 0u ? cnt : 1u;
}

__device__ __forceinline__ void xcd_barrier(const XcdBarrier& b) {
    asm volatile("s_waitcnt vmcnt(0)" ::: "memory");
    __syncthreads();
    if (threadIdx.x == 0) {
        unsigned* bar = b.bar;
        __builtin_amdgcn_s_waitcnt(0);
        unsigned nloc = b.st[0], nx = b.st[1];
        if (nloc == 0u) { xcd_barrier_complete(bar, b.x, nloc, nx); b.st[0] = nloc; b.st[1] = nx; }
        const unsigned old = xb_add(&bar[XB_XSUB(b.x)], 1u);
        const unsigned gen = old / nloc;
        if (old + 1u == (gen + 1u) * nloc) {
            __builtin_amdgcn_fence(__ATOMIC_RELEASE, "agent");
            asm volatile("s_waitcnt vmcnt(0)" ::: "memory");
            const unsigned og = xb_add(&bar[XB_TOP], 1u);
            const unsigned tg = og / nx;
            if (og + 1u == (tg + 1u) * nx) xb_add(&bar[XB_TOPGEN], 1u);
            else XB_SPIN(xb_ld(&bar[XB_TOPGEN]) == tg, bar);
            __builtin_amdgcn_fence(__ATOMIC_ACQUIRE, "agent");
            xb_add(&bar[XB_XGEN(b.x)], 1u);
            asm volatile("s_waitcnt vmcnt(0)" ::: "memory");
        } else {
            XB_SPIN(xb_ld(&bar[XB_XGEN(b.x)]) == gen, bar);
            __builtin_amdgcn_fence(__ATOMIC_ACQUIRE, "agent");
            asm volatile("s_waitcnt vmcnt(0)" ::: "memory");
        }
    }
    __syncthreads();
}


enum { PH_PRO = 0, PH_NORM1, PH_GIN_E, PH_POST_E, PH_FOX, PH_GIN_O, PH_POST_O, PH_NSA, PH_GOUT, PH_NORM2, PH_GQ, PH_SEL, PH_PEER, PH_PEERB };

template <int PH>
__device__ __forceinline__ void run_phase(const P& p, int layer, char* lds, int wv) {
    if (PH == PH_PRO) phase_prologue(p, lds, wv);
    else if (PH == PH_NORM1) phase_norm(p, layer, 0, wv);
    else if (PH == PH_GIN_E) phase_gemm<0>(p, layer, lds, wv);
    else if (PH == PH_POST_E) phase_post_even(p, layer, wv);
    else if (PH == PH_FOX) phase_fox(p, layer, wv);
    else if (PH == PH_GIN_O) phase_gemm<1>(p, layer, lds, wv);
    else if (PH == PH_POST_O) phase_post_odd(p, layer, lds, wv);
    else if (PH == PH_NSA) phase_nsa(p, layer, lds, wv);
    else if (PH == PH_GOUT) phase_gemm<2>(p, layer, lds, wv);
    else if (PH == PH_NORM2) phase_norm2(p, layer, wv);
    else if (PH == PH_GQ) phase_gemm<3>(p, layer, lds, wv);
    else if (PH == PH_SEL) phase_peer_sel(p, layer, lds, wv);
    else if (PH == PH_PEER) phase_peer_a(p, layer, lds, wv);
    else if (PH == PH_PEERB) phase_peer_b6(p, layer, wv);
}

template <int PH>
__global__ void __launch_bounds__(NTHR, 2) k_phase(P p, int layer) {
    __shared__ __attribute__((aligned(16))) char lds[(PH == PH_PRO || PH == PH_NSA || PH == PH_SEL || PH == PH_GIN_E || PH == PH_GIN_O || PH == PH_GOUT || PH == PH_GQ || PH == PH_POST_O || PH == PH_PEER) ? LDS_BYTES : 16];
    run_phase<PH>(p, layer, lds, __builtin_amdgcn_readfirstlane(threadIdx.x >> 6));
}

#ifdef DBG_CHECK
__global__ void k_check(const void* buf, int isbf, size_t rows, int ld, int c0, int nc, int stage, unsigned* flag) {
    bool bad = false;
    const size_t n = rows * (size_t)nc;
    for (size_t i = (size_t)blockIdx.x * blockDim.x + threadIdx.x; i < n; i += (size_t)gridDim.x * blockDim.x) {
        const size_t r = i / nc; const int c = (int)(i - r * nc) + c0;
        float v = isbf ? __uint_as_float(((unsigned)((const bf16_t*)buf)[r * ld + c]) << 16) : ((const float*)buf)[r * ld + c];
        if (!(fabsf(v) < 1e30f)) bad = true;
    }
    if (bad) atomicMax(flag, (unsigned)(1000 - stage));
}
__global__ void k_report(float* o, size_t n, const unsigned* flag) {
    const unsigned f = *flag; const float v = f ? ldexpf(1.f, 1000 - (int)f) : 0.5f;
    for (size_t i = (size_t)blockIdx.x * blockDim.x + threadIdx.x; i < n; i += (size_t)gridDim.x * blockDim.x) o[i] = v;
}
#endif
__global__ void __launch_bounds__(NTHR, 2) k_mega(P p) {
    __shared__ __attribute__((aligned(16))) char lds[LDS_BYTES + 16];
    if (threadIdx.x == 0) *(uint4*)(lds + LDS_BYTES) = make_uint4(0u, 0u, 0u, 0u);
    __syncthreads();
    const int wv = __builtin_amdgcn_readfirstlane(threadIdx.x >> 6);
    (void)xcd_barrier_post(p.bar, (volatile LAS unsigned*)(lds + LDS_BYTES));
#define GRID_BARRIER() do { XcdBarrier b_; b_.bar = p.bar; b_.x = xb_xcc_id(); b_.st = (volatile LAS unsigned*)(lds + LDS_BYTES); xcd_barrier(b_); } while (0)
    run_phase<PH_PRO>(p, 0, lds, wv); GRID_BARRIER(); if (PROBE_REP & 1) { run_phase<PH_PRO>(p, 0, lds, wv); GRID_BARRIER(); }
#define MK_LAYER(layer) do { \
        run_phase<PH_NORM1>(p, layer, lds, wv); GRID_BARRIER(); if (PROBE_REP & (1 << PH_NORM1)) { run_phase<PH_NORM1>(p, layer, lds, wv); GRID_BARRIER(); } \
        if ((layer & 1) == 0) { \
            run_phase<PH_GIN_E>(p, layer, lds, wv); GRID_BARRIER(); if (PROBE_REP & (1 << PH_GIN_E)) { run_phase<PH_GIN_E>(p, layer, lds, wv); GRID_BARRIER(); } \
            run_phase<PH_POST_E>(p, layer, lds, wv); GRID_BARRIER(); \
            run_phase<PH_FOX>(p, layer, lds, wv); GRID_BARRIER(); if (PROBE_REP & (1 << PH_FOX)) { run_phase<PH_FOX>(p, layer, lds, wv); GRID_BARRIER(); } \
        } else { \
            run_phase<PH_GIN_O>(p, layer, lds, wv); GRID_BARRIER(); if (PROBE_REP & (1 << PH_GIN_O)) { run_phase<PH_GIN_O>(p, layer, lds, wv); GRID_BARRIER(); } \
            run_phase<PH_POST_O>(p, layer, lds, wv); GRID_BARRIER(); \
            run_phase<PH_NSA>(p, layer, lds, wv); GRID_BARRIER(); if (PROBE_REP & (1 << PH_NSA)) { run_phase<PH_NSA>(p, layer, lds, wv); GRID_BARRIER(); } \
        } \
        run_phase<PH_GOUT>(p, layer, lds, wv); GRID_BARRIER(); \
        run_phase<PH_NORM2>(p, layer, lds, wv); GRID_BARRIER(); if (PROBE_REP & (1 << PH_NORM2)) { run_phase<PH_NORM2>(p, layer, lds, wv); GRID_BARRIER(); } \
        run_phase<PH_GQ>(p, layer, lds, wv); GRID_BARRIER(); if (PROBE_REP & (1 << PH_GQ)) { run_phase<PH_GQ>(p, layer, lds, wv); GRID_BARRIER(); } \
        run_phase<PH_SEL>(p, layer, lds, wv); GRID_BARRIER(); if (PROBE_REP & (1 << PH_SEL)) { run_phase<PH_SEL>(p, layer, lds, wv); GRID_BARRIER(); } \
        if (PROBE_GHOST & 1) { phase_peer_a<1>(p, layer, lds, wv); GRID_BARRIER(); } \
        run_phase<PH_PEER>(p, layer, lds, wv); GRID_BARRIER(); if (PROBE_GHOST & 2) { phase_peer_b6<1>(p, layer, wv); GRID_BARRIER(); } if (PROBE_REP & (1 << PH_PEER)) { run_phase<PH_PEER>(p, layer, lds, wv); GRID_BARRIER(); } \
        run_phase<PH_PEERB>(p, layer, lds, wv); GRID_BARRIER(); \
} while (0)
    MK_LAYER(0); MK_LAYER(1); MK_LAYER(2); MK_LAYER(3);
}

static inline size_t al256(size_t x) { return (x + 255) & ~(size_t)255; }

extern "C" void kernel_launch(void* const* d_in, const int* in_sizes, int n_in, void* d_out, int out_size, void* d_ws, size_t ws_size, hipStream_t stream) {
    P p{};
    const float** f = (const float**)d_in;
    p.x = f[0]; p.c = f[1]; p.ada_w = f[2]; p.ada_b = f[3]; p.norm_g = f[4]; p.e_w_in = f[5]; p.e_b_f = f[6]; p.e_conv_w = f[7]; p.e_q_g = f[8]; p.e_k_g = f[9]; p.e_w_out = f[10];
    p.o_w_in = f[11]; p.o_b_gate = f[12]; p.o_q_g = f[13]; p.o_k_g = f[14]; p.o_cmp_pos = f[15]; p.o_cmp_w1 = f[16]; p.o_cmp_w2 = f[17]; p.o_w_out = f[18]; p.rel_table = f[19];
    p.p_w_q = f[20]; p.p_keys = f[21]; p.p_u = f[22]; p.p_v = f[23];
    p.out = (float*)d_out;
    char* w = (char*)d_ws; size_t off = 0;
    auto take = [&](size_t bytes) { char* r = w + off; off += al256(bytes); return r; };
    p.bar = (unsigned*)take(16384);
    p.mods = (float*)take((size_t)4 * 8 * 6144 * 4);
    const size_t zero_bytes = off;
    p.c1 = (float*)take(4 * 64 * 4);
    p.winE = (bf16_t*)take((size_t)2 * EVEN_NP * D_ * 2); p.woutE = (bf16_t*)take((size_t)2 * D_ * D_ * 2);
    p.winO = (bf16_t*)take((size_t)2 * ODD_NP * D_ * 2); p.woutO = (bf16_t*)take((size_t)2 * D_ * D_ * 2);
    p.wq = (bf16_t*)take((size_t)4 * D_ * D_ * 2); p.w1t = (bf16_t*)take((size_t)4 * 64 * 2048 * 2); p.w2t = (bf16_t*)take((size_t)4 * 64 * 64 * 2);
    p.keys16 = (bf16_t*)take((size_t)4 * 2 * 128 * 64 * 2);
    p.u8 = (unsigned char*)take((size_t)4 * 16384 * D_); p.v8 = (unsigned char*)take((size_t)4 * 16384 * D_);
    p.h = (bf16_t*)take((size_t)T_ * D_ * 2); p.proj = (bf16_t*)take((size_t)T_ * EVEN_LD * 2); p.cat = (bf16_t*)take((size_t)T_ * D_ * 2);
    p.vT = (bf16_t*)take((size_t)T_ * 512 * 2); p.kt = (bf16_t*)take((size_t)T_ * 512 * 2); p.kc = (bf16_t*)take((size_t)B_ * 4 * 128 * 64 * 2); p.vcT = (bf16_t*)take((size_t)B_ * 4 * 64 * 128 * 2);
    p.fg = (float*)take((size_t)T_ * 48 * 4); p.cum = (float*)take((size_t)64 * S_ * 4); p.gates = (float*)take((size_t)T_ * 48 * 4);
    p.qp = (float*)take((size_t)T_ * D_ * 4); p.selg = (float*)take((size_t)T_ * 128 * 4); p.wexp = (float*)take((size_t)T_ * 128 * 4); p.seli = (int*)take((size_t)T_ * 128 * 4);
    p.h8 = (unsigned char*)take((size_t)T_ * 2048); p.hinv = (float*)take((size_t)T_ * 4); p.winv = (float*)take((size_t)T_ * 4);
    if (off > ws_size) { fprintf(stderr, "kernel_launch: workspace too small (%zu > %zu)\n", off, ws_size); return; }
    (void)hipMemsetAsync(d_ws, 0, zero_bytes, stream);
    const int grid = 256;
#define LAUNCH(PH, layer) hipLaunchKernelGGL((k_phase<PH>), dim3(grid), dim3(NTHR), 0, stream, p, layer)
#ifdef DBG_CHECK
    unsigned* flag = p.bar + 4000;
#define CHK(buf, isbf, rows, ld, c0, nc, stage) hipLaunchKernelGGL(k_check, dim3(1024), dim3(256), 0, stream, (const void*)(buf), isbf, (size_t)(rows), ld, c0, nc, stage, flag)
#else
#define CHK(buf, isbf, rows, ld, c0, nc, stage)
#endif
#if !MK_MULTI
    {
        static int grid1 = 0;
        if (!grid1) {
            int dev = 0, cus = 0, per_cu = 0;
            (void)hipGetDevice(&dev);
            (void)hipDeviceGetAttribute(&cus, hipDeviceAttributeMultiprocessorCount, dev);
            (void)hipOccupancyMaxActiveBlocksPerMultiprocessor(&per_cu, (const void*)k_mega, NTHR, 0);
            if (per_cu < 1) fprintf(stderr, "kernel_launch: occupancy query reports %d blocks per CU\n", per_cu);
            grid1 = cus >= 8 ? (cus / 8) * 8 : 8;
        }
        hipLaunchKernelGGL(k_mega, dim3(grid1), dim3(NTHR), 0, stream, p);
        return;
    }
#endif
    LAUNCH(PH_PRO, 0);
    CHK(p.mods, 0, 32, 6144, 0, 6144, 1); CHK(p.c1, 0, 1, 256, 0, 256, 1);
    CHK(p.winE, 1, 2 * EVEN_NP, D_, 0, D_, 2); CHK(p.woutE, 1, 2 * D_, D_, 0, D_, 2); CHK(p.winO, 1, 2 * ODD_NP, D_, 0, D_, 2); CHK(p.woutO, 1, 2 * D_, D_, 0, D_, 2);
    CHK(p.wq, 1, 4 * D_, D_, 0, D_, 2); CHK(p.w1t, 1, 4 * 64, 2048, 0, 2048, 2); CHK(p.w2t, 1, 4 * 64, 64, 0, 64, 2);

    for (int layer = 0; layer < 4; ++layer) {
        const int sb = 4 + layer * 9;
        LAUNCH(PH_NORM1, layer); CHK(p.h, 1, T_, D_, 0, D_, sb + 0);
        if ((layer & 1) == 0) {
            LAUNCH(PH_GIN_E, layer);
#ifdef DBG_FINE
            CHK(p.proj, 1, T_, EVEN_LD, 0, 512, 5); CHK(p.proj, 1, T_, EVEN_LD, 512, 512, 6); CHK(p.proj, 1, T_, EVEN_LD, 1024, 512, 7); CHK(p.proj, 1, T_, EVEN_LD, 1536, 512, 8); CHK(p.proj, 1, T_, EVEN_LD, 2048, 512, 9);
            CHK(p.vT, 1, T_, 512, 0, 512, 10); CHK(p.fg, 0, T_, 8, 0, 8, 11);
            hipLaunchKernelGGL(k_report, dim3(1024), dim3(256), 0, stream, p.out, (size_t)T_ * D_, (const unsigned*)flag);
            return;
#endif
            CHK(p.proj, 1, T_, EVEN_LD, 0, 2560, sb + 1); CHK(p.vT, 1, T_, 512, 0, 512, sb + 1); CHK(p.fg, 0, T_, 8, 0, 8, sb + 1);
            LAUNCH(PH_POST_E, layer); CHK(p.proj, 1, T_, EVEN_LD, 0, 2560, sb + 2); CHK(p.cat, 1, T_, D_, 0, 512, sb + 2); CHK(p.cum, 0, 64, S_, 0, S_, sb + 2);
            LAUNCH(PH_FOX, layer); CHK(p.cat, 1, T_, D_, 0, D_, sb + 3);
        } else {
            LAUNCH(PH_GIN_O, layer); CHK(p.proj, 1, T_, ODD_LD, 0, 1792, sb + 1); CHK(p.proj, 1, T_, ODD_LD, 2048, 256, sb + 1); CHK(p.vT, 1, T_, 512, 0, 512, sb + 1); CHK(p.fg, 0, T_, 48, 0, 48, sb + 1);
            LAUNCH(PH_POST_O, layer); CHK(p.proj, 1, T_, ODD_LD, 0, 1792, sb + 2); CHK(p.proj, 1, T_, ODD_LD, 2048, 256, sb + 2); CHK(p.gates, 0, T_, 48, 0, 48, sb + 2);
            CHK(p.kc, 1, 32 * 128, 64, 0, 64, sb + 2); CHK(p.vcT, 1, 32 * 64, 128, 0, 128, sb + 2);
            LAUNCH(PH_NSA, layer); CHK(p.cat, 1, T_, D_, 0, D_, sb + 3);
        }
        LAUNCH(PH_GOUT, layer); CHK(p.out, 0, T_, D_, 0, D_, sb + 4);
        LAUNCH(PH_NORM2, layer); CHK(p.h, 1, T_, D_, 0, D_, sb + 5);
        LAUNCH(PH_GQ, layer); CHK(p.qp, 0, T_, D_, 0, D_, sb + 6);
        LAUNCH(PH_SEL, layer); CHK(p.selg, 0, T_, 128, 0, 128, sb + 7);
        LAUNCH(PH_PEER, layer); LAUNCH(PH_PEERB, layer); CHK(p.out, 0, T_, D_, 0, D_, sb + 8);
    }
#ifdef DBG_CHECK
    hipLaunchKernelGGL(k_report, dim3(1024), dim3(256), 0, stream, p.out, (size_t)T_ * D_, (const unsigned*)flag);
#endif
}
```

```cpp
#include <hip/hip_runtime.h>
#include <type_traits>
#include <stdint.h>
#include <stdio.h>

#ifndef MK_SIMPLE_GEMM
#define MK_SIMPLE_GEMM 0
#endif
#ifndef PROBE_GHOST
#define PROBE_GHOST 0
#endif
#ifndef PROBE_REP
#define PROBE_REP 0
#endif
#ifndef MK_MULTI
#define MK_MULTI 0
#endif

typedef unsigned short bf16_t;
typedef short bf16x8 __attribute__((ext_vector_type(8)));
typedef float f32x16 __attribute__((ext_vector_type(16)));
typedef float f32x4 __attribute__((ext_vector_type(4)));
typedef float f32x2 __attribute__((ext_vector_type(2)));
typedef unsigned u32x4 __attribute__((ext_vector_type(4)));
typedef unsigned u32x2 __attribute__((ext_vector_type(2)));
typedef __bf16 bf2_t __attribute__((ext_vector_type(2)));

constexpr int T_ = 16384, D_ = 1024, B_ = 8, S_ = 2048;
constexpr int NTHR = 512, NWV = 8;
constexpr int EVEN_N = 3080, EVEN_NP = 3136, EVEN_LD = 3072;
constexpr int ODD_N = 2608, ODD_NP = 2816, ODD_LD = 2560;
constexpr int LDS_BYTES = 131072;
constexpr float LOG2E = 1.4426950408889634f;

typedef int v8i32 __attribute__((ext_vector_type(8)));
typedef float v16f32 __attribute__((ext_vector_type(16)));
typedef unsigned v6u32 __attribute__((ext_vector_type(6)));
typedef unsigned u32x3 __attribute__((ext_vector_type(3)));
struct P {
    const float *x, *c, *ada_w, *ada_b, *norm_g, *e_w_in, *e_b_f, *e_conv_w, *e_q_g, *e_k_g, *e_w_out;
    const float *o_w_in, *o_b_gate, *o_q_g, *o_k_g, *o_cmp_pos, *o_cmp_w1, *o_cmp_w2, *o_w_out, *rel_table;
    const float *p_w_q, *p_keys, *p_u, *p_v;
    float* out;
    unsigned* bar; float* mods; float* c1;
    bf16_t *winE, *woutE, *winO, *woutO, *wq, *w1t, *w2t, *keys16; unsigned char *u8, *v8;
    bf16_t *h, *proj, *cat, *vT, *kt, *kc, *vcT;
    float *fg, *cum, *gates, *qp, *selg, *wexp; int* seli;
    unsigned char* h8; float *hinv, *winv;
};

__device__ __forceinline__ unsigned cvt_pk_bf16(float lo, float hi) { const f32x2 v = {lo, hi}; const bf2_t b = __builtin_convertvector(v, bf2_t); return __builtin_bit_cast(unsigned, b); }
__device__ __forceinline__ float bf_lo(unsigned w) { return __uint_as_float(w << 16); }
__device__ __forceinline__ float bf_hi(unsigned w) { return __uint_as_float(w & 0xffff0000u); }
__device__ __forceinline__ float bf_to_f(bf16_t v) { return __uint_as_float(((unsigned)v) << 16); }
__device__ __forceinline__ bf16_t f_to_bf(float v) { const __bf16 b = (__bf16)v; return __builtin_bit_cast(bf16_t, b); }
__device__ __forceinline__ float rdlane(float v, int l) { return __int_as_float(__builtin_amdgcn_readlane(__float_as_int(v), l)); }
__device__ __forceinline__ int rdlanei(int v, int l) { return __builtin_amdgcn_readlane(v, l); }

__device__ __forceinline__ int opaque_tid(int wv) { int l; asm volatile("v_mbcnt_lo_u32_b32 %0, -1, 0\n\tv_mbcnt_hi_u32_b32 %0, -1, %0" : "=v"(l)); return wv * 64 + l; }
#define DPPF(old, src, ctrl, rm) __int_as_float(__builtin_amdgcn_update_dpp(__float_as_int(old), __float_as_int(src), ctrl, rm, 0xf, false))
__device__ __forceinline__ float wave_max(float v) {
    v = fmaxf(v, DPPF(v, v, 0xB1, 0xf)); v = fmaxf(v, DPPF(v, v, 0x4E, 0xf)); v = fmaxf(v, DPPF(v, v, 0x141, 0xf)); v = fmaxf(v, DPPF(v, v, 0x140, 0xf));
    v = fmaxf(v, DPPF(-INFINITY, v, 0x142, 0xa)); v = fmaxf(v, DPPF(-INFINITY, v, 0x143, 0xc));
    return rdlane(v, 63);
}
__device__ __forceinline__ float wave_sum(float v) {
    v += DPPF(v, v, 0xB1, 0xf); v += DPPF(v, v, 0x4E, 0xf); v += DPPF(v, v, 0x141, 0xf); v += DPPF(v, v, 0x140, 0xf);
    v += DPPF(0.f, v, 0x142, 0xa); v += DPPF(0.f, v, 0x143, 0xc);
    return rdlane(v, 63);
}
__device__ __forceinline__ unsigned wave_or(unsigned v) {
#define DPPU(old, src, ctrl, rm) ((unsigned)__builtin_amdgcn_update_dpp((int)(old), (int)(src), ctrl, rm, 0xf, false))
    v |= DPPU(v, v, 0xB1, 0xf); v |= DPPU(v, v, 0x4E, 0xf); v |= DPPU(v, v, 0x141, 0xf); v |= DPPU(v, v, 0x140, 0xf);
    v |= DPPU(0u, v, 0x142, 0xa); v |= DPPU(0u, v, 0x143, 0xc);
#undef DPPU
    return (unsigned)__builtin_amdgcn_readlane((int)v, 63);
}
__device__ __forceinline__ float row16_sum(float v) {
    v += DPPF(v, v, 0xB1, 0xf); v += DPPF(v, v, 0x4E, 0xf); v += DPPF(v, v, 0x141, 0xf); v += DPPF(v, v, 0x140, 0xf); return v;
}
__device__ __forceinline__ float oct_sum(float v) {
    v += DPPF(v, v, 0xB1, 0xf); v += DPPF(v, v, 0x4E, 0xf); v += DPPF(v, v, 0x141, 0xf); return v;
}
__device__ __forceinline__ float gelu_tanh(float x) {
    const float y = 0.7978845608028654f * (x + 0.044715f * x * x * x);
    return x / (1.0f + __expf(-2.0f * y));
}
__device__ __forceinline__ f32x16 mfma32(bf16x8 a, bf16x8 b, f32x16 c) { return __builtin_amdgcn_mfma_f32_32x32x16_bf16(a, b, c, 0, 0, 0); }
__device__ __forceinline__ int rowmap(int rho, int h) { return (rho & 3) + 8 * (rho >> 2) + 4 * h; }
__device__ __forceinline__ int koffs(int i, int h) { return (i & 7) + 8 * h + 16 * (i >> 3); }
__device__ __forceinline__ constexpr int kofc(int i) { return (i & 7) + 16 * (i >> 3); }
__device__ __forceinline__ int swap23(int r) { return (r & 3) | (((r >> 3) & 1) << 2) | (((r >> 2) & 1) << 3) | (r & 16); }
__device__ __forceinline__ bf16x8 ld8(const bf16_t* p) { return *(const bf16x8*)p; }
__device__ __forceinline__ size_t ktile_elem(int key, int d) { return (size_t)(key >> 5) * 2048 + (size_t)((((d >> 4) * 2 + ((d >> 3) & 1)) * 32 + swap23(key & 31)) * 8 + (d & 7)); }
__device__ __forceinline__ size_t vtile_elem(int key, int d) { const int kk = key & 31; return (size_t)(key >> 5) * 2048 + (size_t)((((((d >> 5) * 2 + (kk >> 4)) * 2 + ((kk >> 3) & 1)) * 32 + (d & 31)) * 8) + (kk & 7)); }

template <bool SWAP>
__device__ __forceinline__ void gemm_core(const bf16_t* A, const bf16_t* Bt, int K, int m0, int n0, f32x16 (&acc)[2][2], int r, int h) {
    const bf16_t* pa = A + (size_t)(m0 + r) * K + 8 * h;
    const bf16_t* pb = Bt + (size_t)(n0 + r) * K + 8 * h;
    const size_t s32 = (size_t)32 * K;
#pragma unroll
    for (int i = 0; i < 2; ++i)
#pragma unroll
        for (int j = 0; j < 2; ++j)
#pragma unroll
            for (int q = 0; q < 16; ++q) acc[i][j][q] = 0.f;
    bf16x8 a0[2][4], b0[2][4], a1[2][4], b1[2][4];
#define GLOAD(a, b, kk) _Pragma("unroll") for (int i = 0; i < 2; ++i) _Pragma("unroll") for (int ks = 0; ks < 4; ++ks) { a[i][ks] = ld8(pa + i * s32 + (kk) + 16 * ks); b[i][ks] = ld8(pb + i * s32 + (kk) + 16 * ks); }
#define GMMA(a, b) _Pragma("unroll") for (int ks = 0; ks < 4; ++ks) _Pragma("unroll") for (int i = 0; i < 2; ++i) _Pragma("unroll") for (int j = 0; j < 2; ++j) \
        acc[i][j] = SWAP ? mfma32(b[j][ks], a[i][ks], acc[i][j]) : mfma32(a[i][ks], b[j][ks], acc[i][j]);
    GLOAD(a0, b0, 0);
    for (int k0 = 0; k0 < K; k0 += 128) {
        GLOAD(a1, b1, k0 + 64);
        GMMA(a0, b0);
        if (k0 + 128 < K) { GLOAD(a0, b0, k0 + 128); }
        GMMA(a1, b1);
    }
#undef GLOAD
#undef GMMA
}

namespace pg8 {
#define PG8_LAS __attribute__((address_space(3)))
constexpr int BM = 256, BK = 64, HALF = 128, HTB = HALF * BK * 2  , STAGE_BYTES = 8 * HTB, NXCD = 8, WGM = 8;

__host__ __device__ __forceinline__ int lds_byte(int r, int c) { const int st = (r >> 4) * 2 + (c >> 5), rr = r & 15, cc = c & 31, ob = rr * 64 + cc * 2; return st * 1024 + (ob ^ (((ob >> 9) & 1) << 5)); }
__host__ __device__ __forceinline__ void stage_rc(int b, int& R, int& C) { const int st = b / 1024, sb = b % 1024, swz = sb ^ (((sb >> 9) & 1) << 5); R = (st >> 1) * 16 + swz / 64; C = (st & 1) * 32 + (swz % 64) / 2; }
__host__ __device__ __forceinline__ int perm32(int rho) { const int n = rho >> 4, i = rho & 15; return 8 * (i >> 2) + 4 * n + (i & 3); }

struct Unit { int pm, pn; };
struct Gemm { const bf16_t* A; const bf16_t* Bt; int M, N, K; };

struct StaticOrder {
    int nM, nN, nwg, G, c;
    __host__ __device__ void init(int M, int N, int G_, int c_) { nM = M / BM; nN = N / BM; nwg = nM * nN; G = G_; c = c_; }
    __host__ __device__ bool next(int i, Unit& u) const {
        const long L = (long)i * G + c; if (L >= nwg) return false;
        int wgid = (int)L; { const int q = nwg / NXCD, r = nwg % NXCD, xcd = wgid % NXCD, off = wgid / NXCD; wgid = (xcd < r ? xcd * (q + 1) : r * (q + 1) + (xcd - r) * q) + off; }
        const int nig = WGM * nN, gid = wgid / nig, fm = gid * WGM, gsz = (nM - fm) < WGM ? (nM - fm) : WGM;
        u.pm = fm + ((wgid % nig) % gsz); u.pn = (wgid % nig) / gsz; return true;
    }
    __device__ __forceinline__ void a_ready(const Unit&) const {}
    __device__ __forceinline__ void done(const Unit&) const {}
};
template <class Epi, class Sched, bool ALIGN_EPI = false, bool SP2 = false>
__device__ __forceinline__ void gemm_phase(PG8_LAS unsigned char* lds, const Gemm g, const Sched& S, const Epi& E, int wv) {
    const int tid = opaque_tid(wv), wid = __builtin_amdgcn_readfirstlane(tid >> 6), lane = tid & 63, wr = wid >> 2, wc = wid & 3, fr = lane & 15, fq = lane >> 4;
    const int K = g.K, nt = K / BK;
    unsigned voffA[2], voffB[2];
#pragma unroll
    for (int i = 0; i < 2; ++i) { int R, C; stage_rc(tid * 16 + i * 8192, R, C); const int Rb = Epi::PERM ? ((R & ~31) + perm32(R & 31)) : R;
        voffA[i] = (unsigned)(R * K + C) * 2u; voffB[i] = (unsigned)(Rb * K + C) * 2u; }
    const size_t kstep = (size_t)(BK * 2);
    const size_t hstep = (size_t)HALF * K * 2;
    const size_t tstep = 2 * hstep;
    const unsigned ldsw = (unsigned)wid * 1024u;
    const int aoff = lds_byte(wr * 64 + fr, fq * 8), boff = lds_byte(wc * 32 + fr, fq * 8);
#define PG8_SA(b, h) (((b) * 2 + (h)) * HTB)
#define PG8_SB(b, h) ((4 + (b) * 2 + (h)) * HTB)
#define PG8_STAGE(bufoff, gbase, voff) do { _Pragma("unroll") for (int _i = 0; _i < 2; ++_i) \
        __builtin_amdgcn_global_load_lds((const unsigned*)((const char*)(gbase) + (voff)[_i]), (PG8_LAS unsigned*)(lds + (bufoff) + ldsw + _i * 8192), 16, 0, 0); } while (0)
#define PG8_LDA(dst, b, h) do { _Pragma("unroll") for (int m = 0; m < 4; ++m) _Pragma("unroll") for (int k = 0; k < 2; ++k) dst[m][k] = *(const PG8_LAS bf16x8*)(lds + PG8_SA(b, h) + aoff + m * 2048 + k * 1024); } while (0)
#define PG8_LDB(dst, b, h) do { _Pragma("unroll") for (int n = 0; n < 2; ++n) _Pragma("unroll") for (int k = 0; k < 2; ++k) dst[n][k] = *(const PG8_LAS bf16x8*)(lds + PG8_SB(b, h) + boff + n * 2048 + k * 1024); } while (0)
#define PG8_MMA(ai, bj, At, Bt) do { __builtin_amdgcn_s_setprio(1); _Pragma("unroll") for (int m = 0; m < 4; ++m) _Pragma("unroll") for (int n = 0; n < 2; ++n) _Pragma("unroll") for (int k = 0; k < 2; ++k) \
        acc[ai][bj][m][n] = __builtin_amdgcn_mfma_f32_16x16x32_bf16(Bt[n][k], At[m][k], acc[ai][bj][m][n], 0, 0, 0); __builtin_amdgcn_s_setprio(0); } while (0)
#define PG8_WAIT_V(n) asm volatile("s_waitcnt vmcnt(" #n ")" ::: "memory")
#define PG8_WAIT_L(n) asm volatile("s_waitcnt lgkmcnt(" #n ")" ::: "memory")
#define PG8_BAR __builtin_amdgcn_s_barrier()
#define PG8_SCHED __builtin_amdgcn_sched_barrier(0)
    Unit cur, nxt; int ui = 0;
    if (!S.next(0, cur)) return;
    f32x4 acc[2][2][4][2];
#pragma unroll
    for (int a = 0; a < 2; ++a)
#pragma unroll
        for (int b = 0; b < 2; ++b)
#pragma unroll
            for (int m = 0; m < 4; ++m)
#pragma unroll
                for (int n = 0; n < 2; ++n) acc[a][b][m][n] = (f32x4){0.f, 0.f, 0.f, 0.f};
    bf16x8 At[4][2], B0[2][2], B1[2][2];
    const char* cA = (const char*)g.A + (size_t)cur.pm * tstep; const char* cB = (const char*)g.Bt + (size_t)cur.pn * tstep;
    S.a_ready(cur);
    if constexpr (SP2) {
        PG8_STAGE(PG8_SB(0, 0), cB, voffB); PG8_STAGE(PG8_SB(0, 1), cB + hstep, voffB); PG8_STAGE(PG8_SA(0, 0), cA, voffA); PG8_STAGE(PG8_SA(0, 1), cA + hstep, voffA);
        if (wr == 1) PG8_BAR;
        PG8_WAIT_V(2); PG8_BAR;
        PG8_STAGE(PG8_SB(1, 0), cB + kstep, voffB); PG8_STAGE(PG8_SA(1, 0), cA + kstep, voffA); PG8_STAGE(PG8_SB(1, 1), cB + hstep + kstep, voffB);
        PG8_WAIT_V(6); PG8_BAR;
    } else {
        PG8_STAGE(PG8_SB(0, 0), cB, voffB); PG8_STAGE(PG8_SA(0, 0), cA, voffA); PG8_STAGE(PG8_SB(0, 1), cB + hstep, voffB); PG8_STAGE(PG8_SA(0, 1), cA + hstep, voffA);
        if (wr == 1) PG8_BAR;
        PG8_WAIT_V(4); PG8_BAR;
        PG8_STAGE(PG8_SB(1, 0), cB + kstep, voffB); PG8_STAGE(PG8_SA(1, 0), cA + kstep, voffA); PG8_STAGE(PG8_SB(1, 1), cB + hstep + kstep, voffB);
        PG8_WAIT_V(6); PG8_BAR;
    }
    for (;;) {
        const bool has_next = S.next(ui + 1, nxt);
        const char* nA = has_next ? (const char*)g.A + (size_t)nxt.pm * tstep : cA; const char* nB = has_next ? (const char*)g.Bt + (size_t)nxt.pn * tstep : cB;
        for (int t = 0; t < nt; t += 2) {
            const bool last = (t == nt - 2);
            const char* a1 = cA + (size_t)(t + 1) * kstep;
            const char* a2 = last ? nA : cA + (size_t)(t + 2) * kstep; const char* b2 = last ? nB : cB + (size_t)(t + 2) * kstep;
            const char* a3 = a2 + kstep; const char* b3 = b2 + kstep;
            if (last && has_next) S.a_ready(nxt);
            if constexpr (SP2) {
            PG8_LDB(B0, 0, 0); PG8_LDB(B1, 0, 1); PG8_SCHED; PG8_LDA(At, 0, 0); PG8_STAGE(PG8_SA(1, 1), a1 + hstep, voffA);
            PG8_WAIT_V(8); PG8_WAIT_L(0); PG8_BAR; PG8_MMA(0, 0, At, B0); PG8_MMA(0, 1, At, B1); PG8_BAR; PG8_SCHED;
            PG8_LDA(At, 0, 1); PG8_STAGE(PG8_SB(0, 0), b2, voffB); PG8_STAGE(PG8_SB(0, 1), b2 + hstep, voffB); PG8_STAGE(PG8_SA(0, 0), a2, voffA);
            PG8_WAIT_V(8); PG8_WAIT_L(0); PG8_BAR; PG8_MMA(1, 0, At, B0); PG8_MMA(1, 1, At, B1); PG8_BAR; PG8_SCHED;
            PG8_LDB(B0, 1, 0); PG8_LDB(B1, 1, 1); PG8_SCHED; PG8_LDA(At, 1, 0); PG8_STAGE(PG8_SA(0, 1), a2 + hstep, voffA);
            PG8_WAIT_V(8); PG8_WAIT_L(0); PG8_BAR; PG8_MMA(0, 0, At, B0); PG8_MMA(0, 1, At, B1); PG8_BAR; PG8_SCHED;
            PG8_LDA(At, 1, 1); PG8_STAGE(PG8_SB(1, 0), b3, voffB); PG8_STAGE(PG8_SB(1, 1), b3 + hstep, voffB); PG8_STAGE(PG8_SA(1, 0), a3, voffA);
            PG8_WAIT_V(8); PG8_WAIT_L(0); PG8_BAR; PG8_MMA(1, 0, At, B0); PG8_MMA(1, 1, At, B1); PG8_BAR; PG8_SCHED;
            } else {
            PG8_LDB(B0, 0, 0); PG8_SCHED; PG8_LDA(At, 0, 0); PG8_STAGE(PG8_SA(1, 1), a1 + hstep, voffA);
            PG8_WAIT_L(8); PG8_BAR; PG8_WAIT_L(0); PG8_MMA(0, 0, At, B0); PG8_BAR; PG8_SCHED;
            PG8_LDB(B1, 0, 1); PG8_STAGE(PG8_SB(0, 0), b2, voffB);
            PG8_BAR; PG8_WAIT_L(0); PG8_MMA(0, 1, At, B1); PG8_BAR;
            PG8_LDA(At, 0, 1); PG8_STAGE(PG8_SA(0, 0), a2, voffA);
            PG8_BAR; PG8_WAIT_L(0); PG8_MMA(1, 0, At, B0); PG8_BAR; PG8_SCHED;
            PG8_STAGE(PG8_SB(0, 1), b2 + hstep, voffB);
            PG8_WAIT_V(6); PG8_BAR; PG8_MMA(1, 1, At, B1); PG8_BAR;
            PG8_LDB(B0, 1, 0); PG8_SCHED; PG8_LDA(At, 1, 0); PG8_STAGE(PG8_SA(0, 1), a2 + hstep, voffA);
            PG8_WAIT_L(8); PG8_BAR; PG8_WAIT_L(0); PG8_MMA(0, 0, At, B0); PG8_BAR; PG8_SCHED;
            PG8_LDB(B1, 1, 1); PG8_STAGE(PG8_SB(1, 0), b3, voffB);
            PG8_BAR; PG8_WAIT_L(0); PG8_MMA(0, 1, At, B1); PG8_BAR;
            PG8_LDA(At, 1, 1); PG8_STAGE(PG8_SA(1, 0), a3, voffA);
            PG8_BAR; PG8_WAIT_L(0); PG8_MMA(1, 0, At, B0); PG8_BAR; PG8_SCHED;
            PG8_STAGE(PG8_SB(1, 1), b3 + hstep, voffB);
            PG8_WAIT_V(6); PG8_BAR; PG8_MMA(1, 1, At, B1); PG8_BAR;
            }
        }
        if constexpr (ALIGN_EPI) { if (wr == 0) PG8_BAR; }
        if constexpr (!Epi::AFTER_DRAIN) { E(acc, cur, wr, wc, fr, fq); S.done(cur); }
        if (!has_next) break;
#pragma unroll
        for (int a = 0; a < 2; ++a)
#pragma unroll
            for (int b = 0; b < 2; ++b)
#pragma unroll
                for (int m = 0; m < 4; ++m)
#pragma unroll
                    for (int n = 0; n < 2; ++n) acc[a][b][m][n] = (f32x4){0.f, 0.f, 0.f, 0.f};
        cur = nxt; cA = nA; cB = nB; ++ui;
        if constexpr (ALIGN_EPI) { if (wr == 1) PG8_BAR; }
    }
    PG8_WAIT_V(0);
    if constexpr (!ALIGN_EPI) { if (wr == 0) PG8_BAR; }
    PG8_BAR;
    if constexpr (Epi::AFTER_DRAIN) { E.fused(acc, cur, wr, wc, fr, fq, lds, wid, lane); S.done(cur); }
#undef PG8_SA
#undef PG8_SB
#undef PG8_STAGE
#undef PG8_LDA
#undef PG8_LDB
#undef PG8_MMA
#undef PG8_WAIT_V
#undef PG8_WAIT_L
#undef PG8_BAR
#undef PG8_SCHED
}
}

template <int LD, int GT, int GN>
struct EpiIn {
    static constexpr bool PERM = true, AFTER_DRAIN = false;
    bf16_t* proj; float* gl;
    __device__ __forceinline__ void operator()(const f32x4 (&acc)[2][2][4][2], const pg8::Unit& u, int wr, int wc, int fr, int fq) const {
        const int row0 = u.pm * 256 + wr * 64 + fr, col0 = u.pn * 256 + wc * 32 + 8 * fq;
        if (GT < 0 || u.pn != GT) {
#pragma unroll
            for (int ai = 0; ai < 2; ++ai)
#pragma unroll
                for (int m = 0; m < 4; ++m) { bf16_t* rowp = proj + (size_t)(row0 + ai * 128 + m * 16) * LD + col0;
#pragma unroll
                    for (int bj = 0; bj < 2; ++bj) { const f32x4 v0 = acc[ai][bj][m][0], v1 = acc[ai][bj][m][1];
                        u32x4 w; w.x = cvt_pk_bf16(v0[0], v0[1]); w.y = cvt_pk_bf16(v0[2], v0[3]); w.z = cvt_pk_bf16(v1[0], v1[1]); w.w = cvt_pk_bf16(v1[2], v1[3]);
                        *(u32x4*)(rowp + bj * 128) = w; } }
        } else {
            const int c0 = wc * 32 + 8 * fq;
            if (c0 < GN) {
#pragma unroll
                for (int ai = 0; ai < 2; ++ai)
#pragma unroll
                    for (int m = 0; m < 4; ++m) { float* gp = gl + (size_t)(row0 + ai * 128 + m * 16) * GN + c0;
                        *(f32x4*)gp = acc[ai][0][m][0]; *(f32x4*)(gp + 4) = acc[ai][0][m][1]; }
            }
        }
    }
};
struct EpiOut {
    static constexpr bool PERM = false, AFTER_DRAIN = false;
    const float* xold; float* out; const float* g1;
    __device__ __forceinline__ void operator()(const f32x4 (&acc)[2][2][4][2], const pg8::Unit& u, int wr, int wc, int fr, int fq) const {
        const int row0 = u.pm * 256 + wr * 64 + fr, col0 = u.pn * 256 + wc * 32 + 4 * fq;
#pragma unroll
        for (int ai = 0; ai < 2; ++ai)
#pragma unroll
            for (int m = 0; m < 4; ++m) { const int row = row0 + ai * 128 + m * 16; const size_t off = (size_t)row * D_ + col0; const float* gp = g1 + (size_t)(row >> 11) * 6144 + col0;
#pragma unroll
                for (int bj = 0; bj < 2; ++bj)
#pragma unroll
                    for (int n = 0; n < 2; ++n) { const f32x4 xv = *(const f32x4*)(xold + off + bj * 128 + n * 16), gv = *(const f32x4*)(gp + bj * 128 + n * 16);
                        *(f32x4*)(out + off + bj * 128 + n * 16) = xv + gv * acc[ai][bj][m][n]; } }
    }
};
struct EpiF32 {
    static constexpr bool PERM = false, AFTER_DRAIN = false;
    float* out;
    __device__ __forceinline__ void operator()(const f32x4 (&acc)[2][2][4][2], const pg8::Unit& u, int wr, int wc, int fr, int fq) const {
        const int row0 = u.pm * 256 + wr * 64 + fr, col0 = u.pn * 256 + wc * 32 + 4 * fq;
#pragma unroll
        for (int ai = 0; ai < 2; ++ai)
#pragma unroll
            for (int m = 0; m < 4; ++m) { const size_t off = (size_t)(row0 + ai * 128 + m * 16) * D_ + col0;
#pragma unroll
                for (int bj = 0; bj < 2; ++bj)
#pragma unroll
                    for (int n = 0; n < 2; ++n) *(f32x4*)(out + off + bj * 128 + n * 16) = acc[ai][bj][m][n]; }
    }
};

template <int MODE>
__device__ __forceinline__ void phase_gemm_simple(const P& p, int layer, int tn_only, int wv) {
    const int tid = opaque_tid(wv), lane = tid & 63, wid = __builtin_amdgcn_readfirstlane(tid >> 6), r = lane & 31, h = lane >> 5;
    const int li = layer >> 1;
    const bf16_t* A; const bf16_t* Bt; int NP;
    if (MODE == 0) { A = p.h; Bt = p.winE + (size_t)li * EVEN_NP * D_; NP = EVEN_NP; }
    else if (MODE == 1) { A = p.h; Bt = p.winO + (size_t)li * ODD_NP * D_; NP = ODD_NP; }
    else if (MODE == 2) { A = p.cat; Bt = ((layer & 1) ? p.woutO : p.woutE) + (size_t)li * D_ * D_; NP = D_; }
    else { A = p.h; Bt = p.wq + (size_t)layer * D_ * D_; NP = D_; }
    const int nTn = NP / 64, ntiles = (T_ / 64) * nTn;
    const int nw = gridDim.x * NWV;
    for (int tile0 = blockIdx.x * NWV + wid; tile0 < (tn_only >= 0 ? T_ / 64 : ntiles); tile0 += nw) {
        const int tile = tn_only >= 0 ? tile0 * nTn + tn_only : tile0;
        const int tm = tile / nTn, tn = tile - tm * nTn, m0 = tm * 64, n0 = tn * 64;
        bool swp = false;
        if (MODE == 0) swp = (tn >= 40 && tn < 48);
        if (MODE == 1) swp = (tn >= 28 && tn < 32) || (tn >= 36 && tn < 40);
        f32x16 acc[2][2];
        if (swp) {
            gemm_core<true>(A, Bt, D_, m0, n0, acc, r, h);
            int vb, nh; bf16_t* dst;
            if (MODE == 0) { vb = 2560; nh = 8; dst = p.vT; } else if (tn < 32) { vb = 1792; nh = 4; dst = p.vT; } else { vb = 2304; nh = 4; dst = p.vT + (size_t)B_ * 4 * 64 * S_; }
#pragma unroll
            for (int i = 0; i < 2; ++i) {
                const int m = m0 + 32 * i + r, b = m >> 11, s = m & 2047;
#pragma unroll
                for (int j = 0; j < 2; ++j)
#pragma unroll
                    for (int q = 0; q < 16; ++q) {
                        const int n = n0 + 32 * j + rowmap(q, h) - vb; const int hd = n >> 6, d = n & 63;
                        dst[(size_t)(b * nh + hd) * 64 * S_ + vtile_elem(s, d)] = f_to_bf(acc[i][j][q]);
                    }
            }
        } else {
            gemm_core<false>(A, Bt, D_, m0, n0, acc, r, h);
#pragma unroll
            for (int i = 0; i < 2; ++i)
#pragma unroll
                for (int j = 0; j < 2; ++j)
#pragma unroll
                    for (int q = 0; q < 16; ++q) {
                        const int m = m0 + 32 * i + rowmap(q, h), n = n0 + 32 * j + r; const float v = acc[i][j][q];
                        if (MODE == 0) {
                            if (n < EVEN_LD) p.proj[(size_t)m * EVEN_LD + n] = f_to_bf(v);
                            else if (n < EVEN_N) p.fg[(size_t)m * 8 + (n - EVEN_LD)] = v;
                        } else if (MODE == 1) {
                            if (n < ODD_LD) p.proj[(size_t)m * ODD_LD + n] = f_to_bf(v);
                            else if (n < ODD_N) p.fg[(size_t)m * 48 + (n - ODD_LD)] = v;
                        } else if (MODE == 2) {
                            const float* xo = (layer == 0) ? p.x : p.out;
                            const float g1 = p.mods[((size_t)layer * B_ + (m >> 11)) * 6144 + 2048 + n];
                            p.out[(size_t)m * D_ + n] = xo[(size_t)m * D_ + n] + g1 * v;
                        } else {
                            ((bf16_t*)p.qp)[(size_t)m * D_ + n] = f_to_bf(v);
                        }
                    }
        }
    }
}


template <int MODE>
__device__ __forceinline__ void phase_gemm(const P& p, int layer, char* lds, int wv) {
#if MK_SIMPLE_GEMM
    phase_gemm_simple<MODE>(p, layer, -1, wv);
#else
    const int li = layer >> 1;
    PG8_LAS unsigned char* l3 = (PG8_LAS unsigned char*)lds;
    pg8::StaticOrder S;
    if (MODE == 0) {
        pg8::Gemm g{p.h, p.winE + (size_t)li * EVEN_NP * D_, T_, EVEN_LD, D_}; S.init(T_, EVEN_LD, gridDim.x, blockIdx.x);
        EpiIn<EVEN_LD, -1, 8> E{p.proj, nullptr};
        pg8::gemm_phase<EpiIn<EVEN_LD, -1, 8>, pg8::StaticOrder, true, true>(l3, g, S, E, wv);
    } else if (MODE == 1) {
        pg8::Gemm g{p.h, p.winO + (size_t)li * ODD_NP * D_, T_, ODD_NP, D_}; S.init(T_, ODD_NP, gridDim.x, blockIdx.x);
        EpiIn<ODD_LD, 10, 48> E{p.proj, p.fg};
        pg8::gemm_phase<EpiIn<ODD_LD, 10, 48>, pg8::StaticOrder, true, true>(l3, g, S, E, wv);
    } else if (MODE == 2) {
        pg8::Gemm g{p.cat, ((layer & 1) ? p.woutO : p.woutE) + (size_t)li * D_ * D_, T_, D_, D_}; S.init(T_, D_, gridDim.x, blockIdx.x);
        EpiOut E{(layer == 0) ? p.x : p.out, p.out, p.mods + (size_t)layer * B_ * 6144 + 2048};
        pg8::gemm_phase<EpiOut, pg8::StaticOrder, true, true>(l3, g, S, E, wv);
    } else {
        pg8::Gemm g{p.h, p.wq + (size_t)layer * D_ * D_, T_, D_, D_}; S.init(T_, D_, gridDim.x, blockIdx.x);
        EpiIn<D_, -1, 8> E{(bf16_t*)p.qp, nullptr};
        pg8::gemm_phase<EpiIn<D_, -1, 8>, pg8::StaticOrder, true, true>(l3, g, S, E, wv);
    }
#endif
}

__device__ __forceinline__ void convT(const float* src, int K, int N, int NP, bf16_t* dst, float* lt, int tid) {
    const int tk = K / 64, tnn = NP / 64;
    for (int tile = blockIdx.x; tile < tk * tnn; tile += gridDim.x) {
        const int k0 = (tile % tk) * 64, n0 = (tile / tk) * 64;
#pragma unroll
        for (int i = 0; i < 8; ++i) { const int idx = tid + NTHR * i, kk = idx >> 6, nn = idx & 63; lt[nn * 65 + kk] = (n0 + nn < N) ? src[(size_t)(k0 + kk) * N + n0 + nn] : 0.f; }
        __syncthreads();
#pragma unroll
        for (int i = 0; i < 4; ++i) { const int idx = tid + NTHR * i, nn = idx >> 5, kp = (idx & 31) * 2;
            *(unsigned*)(dst + (size_t)(n0 + nn) * K + k0 + kp) = cvt_pk_bf16(lt[nn * 65 + kp], lt[nn * 65 + kp + 1]); }
        __syncthreads();
    }
}
__device__ __forceinline__ void conv_plain(const float* src, bf16_t* dst, size_t n, int tid) {
    const size_t nth = (size_t)gridDim.x * NTHR;
    for (size_t i = (size_t)blockIdx.x * NTHR + tid; i < n / 8; i += nth) {
        const f32x4 a = *(const f32x4*)(src + i * 8), b = *(const f32x4*)(src + i * 8 + 4);
        u32x4 w; w.x = cvt_pk_bf16(a[0], a[1]); w.y = cvt_pk_bf16(a[2], a[3]); w.z = cvt_pk_bf16(b[0], b[1]); w.w = cvt_pk_bf16(b[2], b[3]);
        *(u32x4*)(dst + i * 8) = w;
    }
}
constexpr float V6_SCALE = 4.f;
constexpr float U6_SCALE = 48.f;
__device__ __forceinline__ unsigned enc_e2m3(float x) {
    const unsigned s = (__float_as_uint(x) >> 26) & 0x20u;
    const float a = fminf(fabsf(x), 7.5f);
    const unsigned b = __float_as_uint(a);
    const unsigned cn = ((b + 0x7ffffu + ((b >> 20) & 1u)) >> 20) - (126u << 3);
    const unsigned cs = (unsigned)__builtin_rintf(a * 8.f);
    const unsigned c = (a < 1.f) ? cs : cn;
    return s | (c > 31u ? 31u : c);
}
__device__ __forceinline__ float dec_e2m3(unsigned c) {
    const unsigned c5 = c & 31u;
    const float mag = (c5 < 8u) ? (float)c5 * 0.125f : __uint_as_float((c5 + (126u << 3)) << 20);
    return (c & 32u) ? -mag : mag;
}
__device__ __forceinline__ void conv_fp6_sliced(const float* src, unsigned char* dst, float scale, int tid) {
    const size_t nth = (size_t)gridDim.x * NTHR, n16 = (size_t)4 * 16384 * 64;
    for (size_t i = (size_t)blockIdx.x * NTHR + tid; i < n16; i += nth) {
        const size_t row = i >> 6; const int ch = (int)(i & 63);
        v16f32 ev = {}, od = {};
#pragma unroll
        for (int q = 0; q < 4; ++q) { const f32x4 a = *(const f32x4*)(src + row * D_ + ch * 16 + 4 * q);
            ev[2 * q] = a[0] * scale; od[2 * q] = a[1] * scale; ev[2 * q + 1] = a[2] * scale; od[2 * q + 1] = a[3] * scale; }
        const v6u32 pk = __builtin_amdgcn_cvt_scalef32_2xpk16_fp6_f32(ev, od, 1.0f);
        const size_t layer = row >> 14, ex = row & 16383;
        unsigned* d = (unsigned*)(dst + ((layer * 4 + (ch >> 4)) * 16384 + ex) * 192 + (ch & 15) * 12);
        d[0] = pk[0]; d[1] = pk[1]; d[2] = pk[2];
    }
}
__device__ __forceinline__ void conv_fp6(const float* src, unsigned char* dst, size_t nrows, float scale, int tid) {
    const size_t nth = (size_t)gridDim.x * NTHR;
    for (size_t i = (size_t)blockIdx.x * NTHR + tid; i < nrows * 64; i += nth) {
        const size_t row = i >> 6; const int ch = (int)(i & 63);
        v16f32 ev = {}, od = {};
#pragma unroll
        for (int q = 0; q < 4; ++q) { const f32x4 a = *(const f32x4*)(src + row * D_ + ch * 16 + 4 * q);
            ev[2 * q] = a[0] * scale; od[2 * q] = a[1] * scale; ev[2 * q + 1] = a[2] * scale; od[2 * q + 1] = a[3] * scale; }
        const v6u32 pk = __builtin_amdgcn_cvt_scalef32_2xpk16_fp6_f32(ev, od, 1.0f);
        unsigned* d = (unsigned*)(dst + row * 768 + ch * 12);
        d[0] = pk[0]; d[1] = pk[1]; d[2] = pk[2];
    }
}
struct TDesc { const float* src; bf16_t* dst; int K, N, k0, n0; };
__device__ __forceinline__ bool tdesc_seg(int& g, const float* src, int K, int N, int NP, bf16_t* dst, TDesc& d) {
    const int tk = K / 64, nt = tk * (NP / 64);
    if (g < nt) { d.src = src; d.dst = dst; d.K = K; d.N = N; d.k0 = (g % tk) * 64; d.n0 = (g / tk) * 64; return true; }
    g -= nt; return false;
}
constexpr int TR_TILES = 2 * ((D_ / 64) * (EVEN_NP / 64) + (D_ / 64) * (D_ / 64) + (D_ / 64) * (ODD_NP / 64) + (D_ / 64) * (D_ / 64) + 2 * (32 + 1)) + 4 * (D_ / 64) * (D_ / 64);
__device__ __forceinline__ void tdesc(const P& p, int g, TDesc& d) {
    for (int i = 0; i < 2; ++i) {
        if (tdesc_seg(g, p.e_w_in + (size_t)i * D_ * EVEN_N, D_, EVEN_N, EVEN_NP, p.winE + (size_t)i * EVEN_NP * D_, d)) return;
        if (tdesc_seg(g, p.e_w_out + (size_t)i * D_ * D_, D_, D_, D_, p.woutE + (size_t)i * D_ * D_, d)) return;
        if (tdesc_seg(g, p.o_w_in + (size_t)i * D_ * ODD_N, D_, ODD_N, ODD_NP, p.winO + (size_t)i * ODD_NP * D_, d)) return;
        if (tdesc_seg(g, p.o_w_out + (size_t)i * D_ * D_, D_, D_, D_, p.woutO + (size_t)i * D_ * D_, d)) return;
        for (int kv = 0; kv < 2; ++kv) {
            if (tdesc_seg(g, p.o_cmp_w1 + (size_t)(i * 2 + kv) * 2048 * 64, 2048, 64, 64, p.w1t + (size_t)(i * 2 + kv) * 64 * 2048, d)) return;
            if (tdesc_seg(g, p.o_cmp_w2 + (size_t)(i * 2 + kv) * 64 * 64, 64, 64, 64, p.w2t + (size_t)(i * 2 + kv) * 64 * 64, d)) return;
        }
    }
    for (int l = 0; l < 4; ++l) if (tdesc_seg(g, p.p_w_q + (size_t)l * D_ * D_, D_, D_, D_, p.wq + (size_t)l * D_ * D_, d)) return;
    (void)tdesc_seg(g, p.p_w_q, D_, D_, D_, p.wq, d);
}
__device__ __forceinline__ void conv_transposes(const P& p, float* lt, int tid) {
    if ((int)blockIdx.x >= TR_TILES) return;
    TDesc dn; tdesc(p, blockIdx.x, dn);
    float nx[8];
#pragma unroll
    for (int i = 0; i < 8; ++i) { const int idx = tid + NTHR * i, kk = idx >> 6, nn = idx & 63; nx[i] = (dn.n0 + nn < dn.N) ? dn.src[(size_t)(dn.k0 + kk) * dn.N + dn.n0 + nn] : 0.f; }
    for (int g = blockIdx.x; g < TR_TILES; g += gridDim.x) {
        const TDesc dc = dn; float cv[8];
#pragma unroll
        for (int i = 0; i < 8; ++i) cv[i] = nx[i];
        const int gn = (g + (int)gridDim.x < TR_TILES) ? g + (int)gridDim.x : g;
        tdesc(p, gn, dn);
#pragma unroll
        for (int i = 0; i < 8; ++i) { const int idx = tid + NTHR * i, kk = idx >> 6, nn = idx & 63; nx[i] = (dn.n0 + nn < dn.N) ? dn.src[(size_t)(dn.k0 + kk) * dn.N + dn.n0 + nn] : 0.f; }
#pragma unroll
        for (int i = 0; i < 8; ++i) { const int idx = tid + NTHR * i, kk = idx >> 6, nn = idx & 63; lt[nn * 65 + kk] = cv[i]; }
        __syncthreads();
#pragma unroll
        for (int i = 0; i < 4; ++i) { const int idx = tid + NTHR * i, nn = idx >> 5, kp = (idx & 31) * 2;
            *(unsigned*)(dc.dst + (size_t)(dc.n0 + nn) * dc.K + dc.k0 + kp) = cvt_pk_bf16(lt[nn * 65 + kp], lt[nn * 65 + kp + 1]); }
        __syncthreads();
    }
}
__device__ __forceinline__ void phase_prologue(const P& p, char* lds, int wv) {
    float* lt = (float*)lds;
    const int tid = opaque_tid(wv);
    conv_transposes(p, lt, tid);
    conv_fp6(p.p_u, p.u8, (size_t)4 * 16384, U6_SCALE, tid);
    conv_fp6_sliced(p.p_v, p.v8, V6_SCALE, tid);
    conv_plain(p.p_keys, p.keys16, (size_t)4 * 2 * 128 * 64, tid);
    for (int u = (int)gridDim.x - 1 - (int)blockIdx.x; u < 4; u += gridDim.x) {
        const int cc = tid & 63, ch = tid >> 6; float s = 0.f;
        const float* pos = p.o_cmp_pos + (size_t)u * 2048; const float* w1 = p.o_cmp_w1 + (size_t)u * 2048 * 64;
        for (int k0 = ch * 256; k0 < ch * 256 + 256; k0 += 16) {
            float pv[16], wv16[16];
#pragma unroll
            for (int q = 0; q < 16; ++q) { pv[q] = pos[k0 + q]; wv16[q] = w1[(size_t)(k0 + q) * 64 + cc]; }
#pragma unroll
            for (int q = 0; q < 16; ++q) s += pv[q] * wv16[q];
        }
        __syncthreads(); lt[tid] = s; __syncthreads();
        if (tid < 64) { float t = 0.f; for (int q = 0; q < 8; ++q) t += lt[q * 64 + tid]; p.c1[u * 64 + tid] = t; }
        __syncthreads();
    }
    __syncthreads();
    for (int i = tid; i < 8 * D_; i += NTHR) { const float cv = p.c[i]; lt[i] = cv / (1.f + __expf(-cv)); }
    float* part = lt + 8 * D_;
    __syncthreads();
    for (int u = blockIdx.x; u < 4 * 48; u += gridDim.x) {
        const int l = u / 48, ec = u % 48, col = tid & 127, dq = tid >> 7, e = ec * 128 + col;
        float acc[8];
#pragma unroll
        for (int b = 0; b < 8; ++b) acc[b] = 0.f;
        const float* w = p.ada_w + ((size_t)l * D_ + dq * 256) * 6144 + e;
        for (int d0 = 0; d0 < 256; d0 += 16) {
            float wv[16];
#pragma unroll
            for (int q = 0; q < 16; ++q) wv[q] = w[(size_t)(d0 + q) * 6144];
#pragma unroll
            for (int q = 0; q < 16; q += 4)
#pragma unroll
                for (int b = 0; b < 8; ++b) { const f32x4 sv = *(const f32x4*)(lt + b * D_ + dq * 256 + d0 + q); acc[b] += sv[0] * wv[q] + sv[1] * wv[q + 1] + sv[2] * wv[q + 2] + sv[3] * wv[q + 3]; }
        }
#pragma unroll
        for (int b = 0; b < 8; ++b) part[(dq * 8 + b) * 128 + col] = acc[b];
        __syncthreads();
        for (int i = tid; i < 8 * 128; i += NTHR) { const int b = i >> 7, cc = i & 127;
            const float s = ((part[(0 * 8 + b) * 128 + cc] + part[(1 * 8 + b) * 128 + cc]) + part[(2 * 8 + b) * 128 + cc]) + part[(3 * 8 + b) * 128 + cc];
            p.mods[((size_t)l * B_ + b) * 6144 + ec * 128 + cc] = s + p.ada_b[l * 6144 + ec * 128 + cc]; }
        __syncthreads();
    }
}

__device__ __forceinline__ void phase_norm(const P& p, int layer, int which, int wv) {
    const int tid = opaque_tid(wv), lane = tid & 63, wid = __builtin_amdgcn_readfirstlane(tid >> 6);
    const bool gates = (which == 0) && ((layer & 1) == 0);
    u32x2 wf[8][4];
    if (gates) {
#pragma unroll
        for (int c = 0; c < 8; ++c)
#pragma unroll
            for (int i = 0; i < 4; ++i) wf[c][i] = *(const u32x2*)(p.winE + ((size_t)(layer >> 1) * EVEN_NP + EVEN_LD + c) * D_ + 4 * lane + 256 * i);
    }
    const float* xin = (layer == 0 && which == 0) ? p.x : p.out;
    const float* gain = p.norm_g + (size_t)(layer * 2 + which) * D_;
    const bool aff = (gridDim.x == 256);
    const int t0_ = aff ? 2048 * (int)(blockIdx.x & 7) + (int)(blockIdx.x >> 3) * NWV + wid : (int)blockIdx.x * NWV + wid, tstep_ = aff ? 256 : (int)gridDim.x * NWV;
    const int tend_ = aff ? 2048 * (int)(blockIdx.x & 7) + 2048 : T_;
    f32x4 vn[4];
#pragma unroll
    for (int i = 0; i < 4; ++i) vn[i] = *(const f32x4*)(xin + (size_t)(t0_ < T_ ? t0_ : 0) * D_ + 4 * lane + 256 * i);
    for (int t = t0_; t < tend_; t += tstep_) {
        const int b = t >> 11;
        const float* md = p.mods + ((size_t)layer * B_ + b) * 6144 + which * 3072;
        f32x4 v[4]; float ss = 0.f;
        const int tnx = (t + tstep_ < tend_) ? t + tstep_ : t;
#pragma unroll
        for (int i = 0; i < 4; ++i) { v[i] = vn[i]; vn[i] = *(const f32x4*)(xin + (size_t)tnx * D_ + 4 * lane + 256 * i); ss += v[i][0] * v[i][0] + v[i][1] * v[i][1] + v[i][2] * v[i][2] + v[i][3] * v[i][3]; }
        ss = wave_sum(ss);
        const float rs = rsqrtf(ss * (1.f / D_) + 1e-6f);
        float fd[8];
        float yk[4][4], amax = 1e-30f;
#pragma unroll
        for (int c = 0; c < 8; ++c) fd[c] = 0.f;
#pragma unroll
        for (int i = 0; i < 4; ++i) {
            const int e = 4 * lane + 256 * i;
            const f32x4 g = *(const f32x4*)(gain + e), sh = *(const f32x4*)(md + e), sc = *(const f32x4*)(md + 1024 + e);
            float y[4];
#pragma unroll
            for (int q = 0; q < 4; ++q) y[q] = v[i][q] * rs * g[q] * (1.f + sc[q]) + sh[q];
            u32x2 w; w.x = cvt_pk_bf16(y[0], y[1]); w.y = cvt_pk_bf16(y[2], y[3]);
            *(u32x2*)(p.h + (size_t)t * D_ + e) = w;
            if (which == 1) {
#pragma unroll
                for (int q = 0; q < 4; ++q) { yk[i][q] = y[q]; amax = fmaxf(amax, fabsf(y[q])); }
            }
            if (gates) {
#pragma unroll
                for (int c = 0; c < 8; ++c) fd[c] += bf_lo(w.x) * bf_lo(wf[c][i].x) + bf_hi(w.x) * bf_hi(wf[c][i].x) + bf_lo(w.y) * bf_lo(wf[c][i].y) + bf_hi(w.y) * bf_hi(wf[c][i].y);
            }
        }
        if (which == 1) {
            const float am = wave_max(amax), sc = 7.5f / am;
#pragma unroll
            for (int i = 0; i < 4; ++i) {
                unsigned hi = 0u, lo = 0u;
#pragma unroll
                for (int q = 0; q < 4; ++q) {
                    const float a = yk[i][q] * sc; const unsigned ch = enc_e2m3(a), c5 = ch & 31u;
                    const float mag = (c5 < 8u) ? (float)c5 * 0.125f : __uint_as_float((c5 + (126u << 3)) << 20);
                    const float back = (ch & 32u) ? -mag : mag;
                    hi |= ch << (8 * q); lo |= enc_e2m3(a - back) << (8 * q);
                }
                *(unsigned*)(p.h8 + (size_t)t * 2048 + 4 * lane + 256 * i) = hi; *(unsigned*)(p.h8 + (size_t)t * 2048 + 1024 + 4 * lane + 256 * i) = lo;
            }
            if (lane == 0) p.hinv[t] = am * (1.f / 7.5f);
        }
        if (gates) {
            float mine = 0.f;
#pragma unroll
            for (int c = 0; c < 8; ++c) { const float s = wave_sum(fd[c]); mine = (lane == c) ? s : mine; }
            if (lane < 8) p.fg[(size_t)t * 8 + lane] = mine;
        }
    }
}

__device__ __forceinline__ float q_e2m3(float a) {
    const float m = fminf(fabsf(a), 7.5f);
    const unsigned b = __float_as_uint(m);
    const float qn = __uint_as_float((b + 0x7ffffu + ((b >> 20) & 1u)) & 0xfff00000u);
    const float qs = __builtin_rintf(m * 8.f) * 0.125f;
    const float q = fminf((m < 1.f) ? qs : qn, 7.5f);
    return __builtin_copysignf(q, a);
}
__device__ __forceinline__ void phase_norm2(const P& p, int layer, int wv) {
    const int tid = opaque_tid(wv), lane = tid & 63, wid = __builtin_amdgcn_readfirstlane(tid >> 6);
    const float* xin = p.out;
    const float* gain = p.norm_g + (size_t)(layer * 2 + 1) * D_ + 16 * lane;
    f32x4 g[4];
#pragma unroll
    for (int i = 0; i < 4; ++i) g[i] = *(const f32x4*)(gain + 4 * i);
    const bool aff = (gridDim.x == 256);
    const int t0_ = aff ? 2048 * (int)(blockIdx.x & 7) + (int)(blockIdx.x >> 3) * NWV + wid : (int)blockIdx.x * NWV + wid, tstep_ = aff ? 256 : (int)gridDim.x * NWV;
    const int tend_ = aff ? 2048 * (int)(blockIdx.x & 7) + 2048 : T_;
    f32x4 vn[4];
#pragma unroll
    for (int i = 0; i < 4; ++i) vn[i] = *(const f32x4*)(xin + (size_t)(t0_ < T_ ? t0_ : 0) * D_ + 16 * lane + 4 * i);
    for (int t = t0_; t < tend_; t += tstep_) {
        const int b = t >> 11;
        const float* md = p.mods + ((size_t)layer * B_ + b) * 6144 + 3072 + 16 * lane;
        f32x4 v[4]; float ss = 0.f;
        const int tnx = (t + tstep_ < tend_) ? t + tstep_ : t;
#pragma unroll
        for (int i = 0; i < 4; ++i) { v[i] = vn[i]; vn[i] = *(const f32x4*)(xin + (size_t)tnx * D_ + 16 * lane + 4 * i); ss += v[i][0] * v[i][0] + v[i][1] * v[i][1] + v[i][2] * v[i][2] + v[i][3] * v[i][3]; }
        ss = wave_sum(ss);
        const float rs = rsqrtf(ss * (1.f / D_) + 1e-6f);
        float y[16], amax = 1e-30f;
        unsigned hw[8];
#pragma unroll
        for (int i = 0; i < 4; ++i) {
            const f32x4 sh = *(const f32x4*)(md + 4 * i), sc = *(const f32x4*)(md + 1024 + 4 * i);
#pragma unroll
            for (int q = 0; q < 4; ++q) { y[4 * i + q] = v[i][q] * rs * g[i][q] * (1.f + sc[q]) + sh[q]; amax = fmaxf(amax, fabsf(y[4 * i + q])); }
            hw[2 * i] = cvt_pk_bf16(y[4 * i], y[4 * i + 1]); hw[2 * i + 1] = cvt_pk_bf16(y[4 * i + 2], y[4 * i + 3]);
        }
        *(u32x4*)(p.h + (size_t)t * D_ + 16 * lane) = (u32x4){hw[0], hw[1], hw[2], hw[3]}; *(u32x4*)(p.h + (size_t)t * D_ + 16 * lane + 8) = (u32x4){hw[4], hw[5], hw[6], hw[7]};
        const float am = wave_max(amax), scl = 7.5f / am;
        v16f32 eh = {}, oh = {}, el = {}, ol = {};
#pragma unroll
        for (int i = 0; i < 8; ++i) {
            const float a0 = y[2 * i] * scl, a1 = y[2 * i + 1] * scl;
            eh[i] = a0; oh[i] = a1; el[i] = a0 - q_e2m3(a0); ol[i] = a1 - q_e2m3(a1);
        }
        const v6u32 ph = __builtin_amdgcn_cvt_scalef32_2xpk16_fp6_f32(eh, oh, 1.0f), pl = __builtin_amdgcn_cvt_scalef32_2xpk16_fp6_f32(el, ol, 1.0f);
        unsigned* d = (unsigned*)(p.h8 + (size_t)t * 1536 + 24 * lane);
        *(u32x2*)d = (u32x2){ph[0], ph[1]}; *(u32x2*)(d + 2) = (u32x2){ph[2], pl[0]}; *(u32x2*)(d + 4) = (u32x2){pl[1], pl[2]};
        if (lane == 0) p.hinv[t] = am * (1.f / 7.5f);
    }
}

__device__ __forceinline__ void unpack8(u32x4 w, float (&f)[8]) { f[0] = bf_lo(w.x); f[1] = bf_hi(w.x); f[2] = bf_lo(w.y); f[3] = bf_hi(w.y); f[4] = bf_lo(w.z); f[5] = bf_hi(w.z); f[6] = bf_lo(w.w); f[7] = bf_hi(w.w); }
__device__ __forceinline__ u32x4 pack8(const float (&f)[8]) { u32x4 w; w.x = cvt_pk_bf16(f[0], f[1]); w.y = cvt_pk_bf16(f[2], f[3]); w.z = cvt_pk_bf16(f[4], f[5]); w.w = cvt_pk_bf16(f[6], f[7]); return w; }
__device__ __forceinline__ void headnorm8(bf16_t* ptr, const float* gain8, bf16_t* dst = nullptr) {
    float f[8]; unpack8(*(const u32x4*)ptr, f);
    float ss = 0.f;
#pragma unroll
    for (int q = 0; q < 8; ++q) ss += f[q] * f[q];
    ss = oct_sum(ss);
    const float rs = rsqrtf(ss * (1.f / 64.f) + 1e-6f);
#pragma unroll
    for (int q = 0; q < 8; ++q) f[q] = f[q] * rs * gain8[q];
    *(u32x4*)(dst ? dst : ptr) = pack8(f);
}
__device__ __forceinline__ void v_tile8(const bf16_t* src, int ld, bf16_t* dstbase, int s0, int dd0) {
    u32x4 tk[8];
#pragma unroll
    for (int i = 0; i < 8; ++i) tk[i] = *(const u32x4*)(src + (size_t)i * ld);
#pragma unroll
    for (int e = 0; e < 8; ++e) {
        u32x4 o;
#pragma unroll
        for (int pq = 0; pq < 4; ++pq) {
            const unsigned a = tk[2 * pq][e >> 1], b = tk[2 * pq + 1][e >> 1];
            o[pq] = (e & 1) ? ((a >> 16) | (b & 0xffff0000u)) : ((a & 0xffffu) | (b << 16));
        }
        *(u32x4*)(dstbase + vtile_elem(s0, dd0 + e)) = o;
    }
}
__device__ __forceinline__ void phase_post_even(const P& p, int layer, int wv) {
    const int tid = opaque_tid(wv), lane = tid & 63, wid = __builtin_amdgcn_readfirstlane(tid >> 6), li = layer >> 1;
    const float* cw = p.e_conv_w + (size_t)li * 3 * 512;
    const int c0 = 8 * lane;
    float w0[8], w1[8], w2[8], qg[8], kg[8];
#pragma unroll
    for (int q = 0; q < 8; ++q) { w0[q] = cw[c0 + q]; w1[q] = cw[512 + c0 + q]; w2[q] = cw[1024 + c0 + q]; qg[q] = p.e_q_g[li * 64 + ((c0 + q) & 63)]; kg[q] = p.e_k_g[li * 64 + ((c0 + q) & 63)]; }
    const int gw = blockIdx.x * NWV + wid, nw = gridDim.x * NWV;
    const bool aff = (gridDim.x == 256);
    const int ax = (int)(blockIdx.x & 7), aj = (int)(blockIdx.x >> 3) * NWV + wid;
    const int tA0 = aff ? 2048 * ax + aj : gw, tAs = aff ? 256 : nw, tAe = aff ? 2048 * ax + 2048 : T_;
    const int gA0 = aff ? 256 * ax + aj : gw, gAs = aff ? 256 : nw, gAe = aff ? 256 * ax + 256 : T_ / 8;
    for (int t = tA0; t < tAe; t += tAs) {
        const int s = t & 2047;
        bf16_t* row = p.proj + (size_t)t * EVEN_LD;
        float cb[8], a[8], b[8], u0[8], u1[8], u2[8];
        unpack8(*(const u32x4*)(row + c0), cb);
        unpack8(*(const u32x4*)(row + 512 + c0), a); unpack8(*(const u32x4*)(row + 1024 + c0), b);
#pragma unroll
        for (int q = 0; q < 8; ++q) u0[q] = a[q] * b[q];
        if (s >= 1) { unpack8(*(const u32x4*)(row - EVEN_LD + 512 + c0), a); unpack8(*(const u32x4*)(row - EVEN_LD + 1024 + c0), b);
#pragma unroll
            for (int q = 0; q < 8; ++q) u1[q] = a[q] * b[q]; }
        else {
#pragma unroll
            for (int q = 0; q < 8; ++q) u1[q] = 0.f; }
        if (s >= 2) { unpack8(*(const u32x4*)(row - 2 * EVEN_LD + 512 + c0), a); unpack8(*(const u32x4*)(row - 2 * EVEN_LD + 1024 + c0), b);
#pragma unroll
            for (int q = 0; q < 8; ++q) u2[q] = a[q] * b[q]; }
        else {
#pragma unroll
            for (int q = 0; q < 8; ++q) u2[q] = 0.f; }
        float o[8];
#pragma unroll
        for (int q = 0; q < 8; ++q) o[q] = cb[q] * (w0[q] * u2[q] + w1[q] * u1[q] + w2[q] * u0[q]);
        *(u32x4*)(p.cat + (size_t)t * D_ + c0) = pack8(o);
        headnorm8(row + 1536 + c0, qg);
        headnorm8(row + 2048 + c0, kg, p.kt + (size_t)((t >> 11) * 8 + (lane >> 3)) * 64 * S_ + ktile_elem(s, c0 & 63));
    }
    for (int grp = gA0; grp < gAe; grp += gAs) {
        const int t0 = grp * 8;
        v_tile8(p.proj + (size_t)t0 * EVEN_LD + 2560 + c0, EVEN_LD, p.vT + (size_t)((t0 >> 11) * 8 + (lane >> 3)) * 64 * S_, t0 & 2047, c0 & 63);
    }
    for (int sq = gw; sq < 64; sq += nw) {
        const int b = sq >> 3, hd = sq & 7; const float bf = p.e_b_f[li * 8 + hd];
        float v[32]; float run = 0.f;
#pragma unroll
        for (int i = 0; i < 32; ++i) {
            const float z = p.fg[((size_t)b * S_ + lane * 32 + i) * 8 + hd] + bf;
            const float ls = fminf(z, 0.f) - log1pf(expf(-fabsf(z)));
            run += ls; v[i] = run;
        }
        float incl = run;
#pragma unroll
        for (int d = 1; d < 64; d <<= 1) { const float o = __shfl_up(incl, d); if (lane >= d) incl += o; }
        const float excl = incl - run;
#pragma unroll
        for (int i = 0; i < 32; ++i) p.cum[(size_t)sq * S_ + lane * 32 + i] = (v[i] + excl) * LOG2E;
    }
}

struct AttnAcc { f32x16 o[2]; float m, l; };
__device__ __forceinline__ void attn_init(AttnAcc& a) {
#pragma unroll
    for (int q = 0; q < 16; ++q) { a.o[0][q] = 0.f; a.o[1][q] = 0.f; }
    a.m = -INFINITY; a.l = 0.f;
}
__device__ __forceinline__ f32x16 attn_scores(const bf16_t* kbase, int ldk, const bf16x8 (&qf)[4], int r, int h) {
    const bf16_t* kp = kbase + (size_t)swap23(r) * ldk + 8 * h;
    bf16x8 kf[4];
#pragma unroll
    for (int ks = 0; ks < 4; ++ks) kf[ks] = ld8(kp + 16 * ks);
    f32x16 s;
#pragma unroll
    for (int q = 0; q < 16; ++q) s[q] = 0.f;
#pragma unroll
    for (int ks = 0; ks < 4; ++ks) s = mfma32(kf[ks], qf[ks], s);
    return s;
}
__device__ __forceinline__ void attn_update(AttnAcc& a, const f32x16& s, const bf16_t* vt, int ldv, int r, int h) {
    bf16x8 vf[2][2];
#pragma unroll
    for (int db = 0; db < 2; ++db)
#pragma unroll
        for (int ks = 0; ks < 2; ++ks) vf[db][ks] = ld8(vt + (size_t)(32 * db + r) * ldv + 16 * ks + 8 * h);
    float mx = s[0];
#pragma unroll
    for (int q = 1; q < 16; ++q) mx = fmaxf(mx, s[q]);
    mx = fmaxf(mx, __shfl_xor(mx, 32));
    const float mn = fmaxf(a.m, mx), ms = (mn == -INFINITY) ? 0.f : mn;
    const float alpha = __expf(a.m - ms);
    float pv[16], ps = 0.f;
#pragma unroll
    for (int q = 0; q < 16; ++q) { pv[q] = __expf(s[q] - ms); ps += pv[q]; }
    a.l = a.l * alpha + ps; a.m = mn;
#pragma unroll
    for (int q = 0; q < 16; ++q) { a.o[0][q] *= alpha; a.o[1][q] *= alpha; }
    union { bf16x8 v; unsigned u[4]; } pf[2];
#pragma unroll
    for (int ks = 0; ks < 2; ++ks)
#pragma unroll
        for (int q = 0; q < 4; ++q) pf[ks].u[q] = cvt_pk_bf16(pv[8 * ks + 2 * q], pv[8 * ks + 2 * q + 1]);
#pragma unroll
    for (int db = 0; db < 2; ++db)
#pragma unroll
        for (int ks = 0; ks < 2; ++ks) a.o[db] = mfma32(vf[db][ks], pf[ks].v, a.o[db]);
}

struct KF { bf16x8 k[4]; };
struct VF { bf16x8 v[2][2]; };
typedef __amdgpu_buffer_rsrc_t rsrc_t;
__device__ __forceinline__ rsrc_t mk_rsrc(const void* base, unsigned bytes) { return __builtin_amdgcn_make_buffer_rsrc((void*)base, 0, bytes, 0x00020000); }
__device__ __forceinline__ bf16x8 bld8(rsrc_t rs, unsigned voff, unsigned soff) { return __builtin_bit_cast(bf16x8, __builtin_amdgcn_raw_buffer_load_b128(rs, voff, soff, 0)); }
__device__ __forceinline__ void k_load(KF& f, rsrc_t rs, unsigned lo16, unsigned sk) {
    sk = __builtin_amdgcn_readfirstlane(sk);
#pragma unroll
    for (int ks = 0; ks < 4; ++ks) f.k[ks] = bld8(rs, lo16, sk + 1024 * ks);
}
__device__ __forceinline__ void v_load(VF& f, rsrc_t rs, unsigned lo16, unsigned sv) {
    sv = __builtin_amdgcn_readfirstlane(sv);
#pragma unroll
    for (int db = 0; db < 2; ++db)
#pragma unroll
        for (int ks = 0; ks < 2; ++ks) f.v[db][ks] = bld8(rs, lo16, sv + 1024 * (db * 2 + ks));
}
__device__ __forceinline__ f32x16 kv_scores(const KF& f, const bf16x8 (&qf)[4]) {
    f32x16 s;
#pragma unroll
    for (int q = 0; q < 16; ++q) s[q] = 0.f;
#pragma unroll
    for (int ks = 0; ks < 4; ++ks) s = mfma32(f.k[ks], qf[ks], s);
    return s;
}
__device__ __forceinline__ void kv_update(AttnAcc& a, const f32x16& s, const VF& f) {
    float mx = s[0];
#pragma unroll
    for (int q = 1; q < 16; ++q) mx = fmaxf(mx, s[q]);
    mx = fmaxf(mx, __shfl_xor(mx, 32));
    const float mn = fmaxf(a.m, mx), ms = (mn == -INFINITY) ? 0.f : mn;
    const float alpha = __expf(a.m - ms);
    float pv[16], ps = 0.f;
#pragma unroll
    for (int q = 0; q < 16; ++q) { pv[q] = __expf(s[q] - ms); ps += pv[q]; }
    a.l = a.l * alpha + ps; a.m = mn;
#pragma unroll
    for (int q = 0; q < 16; ++q) { a.o[0][q] *= alpha; a.o[1][q] *= alpha; }
    union { bf16x8 v; unsigned u[4]; } pf[2];
#pragma unroll
    for (int ks = 0; ks < 2; ++ks)
#pragma unroll
        for (int q = 0; q < 4; ++q) pf[ks].u[q] = cvt_pk_bf16(pv[8 * ks + 2 * q], pv[8 * ks + 2 * q + 1]);
#pragma unroll
    for (int db = 0; db < 2; ++db)
#pragma unroll
        for (int ks = 0; ks < 2; ++ks) a.o[db] = mfma32(f.v[db][ks], pf[ks].v, a.o[db]);
}

struct AccF { f32x16 o[2]; float l; };
__device__ __forceinline__ void accf_init(AccF& a) {
#pragma unroll
    for (int q = 0; q < 16; ++q) { a.o[0][q] = 0.f; a.o[1][q] = 0.f; }
    a.l = 0.f;
}
__device__ __forceinline__ void kv_update_fixed(AccF& a, const float (&pv)[16], const VF& f) {
    float ps = 0.f;
#pragma unroll
    for (int q = 0; q < 16; ++q) ps += pv[q];
    a.l += ps;
    union { bf16x8 v; unsigned u[4]; } pf[2];
#pragma unroll
    for (int ks = 0; ks < 2; ++ks)
#pragma unroll
        for (int q = 0; q < 4; ++q) pf[ks].u[q] = cvt_pk_bf16(pv[8 * ks + 2 * q], pv[8 * ks + 2 * q + 1]);
#pragma unroll
    for (int db = 0; db < 2; ++db)
#pragma unroll
        for (int ks = 0; ks < 2; ++ks) a.o[db] = mfma32(f.v[db][ks], pf[ks].v, a.o[db]);
}
__device__ __forceinline__ void phase_fox(const P& p, int layer, int wv) {
    const int tid = opaque_tid(wv), lane = tid & 63, wid = __builtin_amdgcn_readfirstlane(tid >> 6), r = lane & 31, h = lane >> 5, li = layer >> 1;
    const int nw = gridDim.x * NWV;
    const float M2 = 8.f * wave_max(fabsf(p.e_q_g[li * 64 + lane])) * wave_max(fabsf(p.e_k_g[li * 64 + lane])) * LOG2E;
    const float c1 = 0.125f * LOG2E;
    for (int u0 = blockIdx.x * NWV + wid; u0 < 2048; u0 += nw) {
        int u = u0;
        if (gridDim.x == 256) { const int xg = blockIdx.x & 7, w = (blockIdx.x >> 3) * NWV + wid; u = ((xg * 8 + (w >> 5)) << 5) | (w & 31); }
        const int b = u >> 8, hd = (u >> 5) & 7, ii = u & 31;
        const float* cumrow = p.cum + (size_t)(b * 8 + hd) * S_;
        const rsrc_t rsK = mk_rsrc(p.kt, (unsigned)((size_t)T_ * 512 * 2)), rsV = mk_rsrc(p.vT, (unsigned)((size_t)T_ * 512 * 2));
        const unsigned kb = (unsigned)((size_t)(b * 8 + hd) * 64 * S_ * 2), vtb = kb;
        for (int half = 0; half < 2; ++half) {
            const int qt = half ? (63 - ii) : ii, q0 = qt * 32, tq = q0 + r;
            const size_t t = (size_t)b * S_ + tq;
            bf16x8 qf[4];
#pragma unroll
            for (int ks = 0; ks < 4; ++ks) qf[ks] = ld8(p.proj + t * EVEN_LD + 1536 + hd * 64 + 16 * ks + 8 * h);
            const float ctm = cumrow[tq] - M2;
            int rdiag = r - 8 * h; asm volatile("" : "+v"(rdiag));
            AccF a; accf_init(a);
            KF cur, nxt; VF vcur, vnxt; f32x4 cc[4], cn[4];
            const unsigned lo16 = (unsigned)lane * 16u;
            k_load(cur, rsK, lo16, kb); v_load(vcur, rsV, lo16, vtb);
#pragma unroll
            for (int q = 0; q < 4; ++q) cc[q] = *(const f32x4*)(cumrow + 16 * (q >> 1) + 8 * h + 4 * (q & 1));
#pragma unroll 1
            for (int k0 = 0; k0 <= q0; k0 += 32) {
                { const int kn = (k0 + 32 <= q0) ? k0 + 32 : k0;
                    v_load(vnxt, rsV, lo16, vtb + (unsigned)kn * 128u);
                    k_load(nxt, rsK, lo16, kb + (unsigned)kn * 128u);
#pragma unroll
                    for (int q = 0; q < 4; ++q) cn[q] = *(const f32x4*)(cumrow + kn + 16 * (q >> 1) + 8 * h + 4 * (q & 1));
                }
                const f32x16 s = kv_scores(cur, qf);
                float pv[16];
#pragma unroll
                for (int q = 0; q < 16; ++q) pv[q] = __builtin_amdgcn_exp2f(fmaf(s[q], c1, ctm - cc[q >> 2][q & 3]));
                if (k0 == q0) {
#pragma unroll
                    for (int q = 0; q < 16; ++q) pv[q] = (kofc(q) <= rdiag) ? pv[q] : 0.f;
                }
                kv_update_fixed(a, pv, vcur);
                cur = nxt; vcur = vnxt;
#pragma unroll
                for (int q = 0; q < 4; ++q) cc[q] = cn[q];
            }
            const float lt = a.l + __shfl_xor(a.l, 32), inv = 1.f / lt;
            bf16_t* dst = p.cat + t * D_ + 512 + hd * 64;
#pragma unroll
            for (int db = 0; db < 2; ++db)
#pragma unroll
                for (int g4 = 0; g4 < 4; ++g4) {
                    u32x2 w; w.x = cvt_pk_bf16(a.o[db][4 * g4] * inv, a.o[db][4 * g4 + 1] * inv); w.y = cvt_pk_bf16(a.o[db][4 * g4 + 2] * inv, a.o[db][4 * g4 + 3] * inv);
                    *(u32x2*)(dst + 32 * db + 8 * g4 + 4 * h) = w;
                }
        }
    }
}

__device__ __forceinline__ void phase_post_odd(const P& p, int layer, char* lds, int wv) {
    const int tid = opaque_tid(wv), lane = tid & 63, wid = __builtin_amdgcn_readfirstlane(tid >> 6), li = layer >> 1, r = lane & 31, h = lane >> 5;
    const int c0 = 8 * lane;
    float qg[8], k1[8], k2[8];
#pragma unroll
    for (int q = 0; q < 8; ++q) { qg[q] = p.o_q_g[li * 64 + ((c0 + q) & 63)]; k1[q] = p.o_k_g[(li * 3 + 1) * 64 + ((c0 + q) & 63)]; k2[q] = p.o_k_g[(li * 3 + 2) * 64 + ((c0 + q) & 63)]; }
    const int gw = blockIdx.x * NWV + wid, nw = gridDim.x * NWV;
    const bool aff = (gridDim.x == 256);
    const int ax = (int)(blockIdx.x & 7), aj = (int)(blockIdx.x >> 3) * NWV + wid;
    const int tA0 = aff ? 2048 * ax + aj : gw, tAs = aff ? 256 : nw, tAe = aff ? 2048 * ax + 2048 : T_;
    const int gA0 = aff ? 256 * ax + aj : gw, gAs = aff ? 256 : nw, gAe = aff ? 256 * ax + 256 : T_ / 8;
    for (int t = tA0; t < tAe; t += tAs) {
        bf16_t* row = p.proj + (size_t)t * ODD_LD;
        headnorm8(row + c0, qg); headnorm8(row + 512 + c0, qg);
        { float kg[8];
#pragma unroll
          for (int q = 0; q < 8; ++q) kg[q] = (lane < 32) ? k1[q] : k2[q];
          const int cg = (lane & 31) * 8;
          headnorm8((lane < 32) ? (row + 1536 + c0) : (row + 2048 + (c0 - 256)), kg,
                    p.kt + (lane < 32 ? (size_t)0 : (size_t)B_ * 4 * 64 * S_) + (size_t)((t >> 11) * 4 + (cg >> 6)) * 64 * S_ + ktile_elem(t & 2047, cg & 63)); }
        if (lane < 48) { const float z = p.fg[(size_t)t * 48 + lane] + p.o_b_gate[li * 48 + lane]; p.gates[(size_t)t * 48 + lane] = 1.f / (1.f + __expf(-z)); }
    }
    for (int grp = gA0; grp < gAe; grp += gAs) {
        const int t0 = grp * 8, cg = (lane & 31) * 8;
        v_tile8(p.proj + (size_t)t0 * ODD_LD + (lane < 32 ? 1792 : 2304) + cg, ODD_LD,
                p.vT + (lane < 32 ? (size_t)0 : (size_t)B_ * 4 * 64 * S_) + (size_t)((t0 >> 11) * 4 + (cg >> 6)) * 64 * S_, t0 & 2047, cg & 63);
    }
    float* part = (float*)lds;
    for (int u0 = blockIdx.x; u0 < 256; u0 += gridDim.x) {
        const int u = (gridDim.x == 256) ? ((u0 >> 3) & 16) * 8 + (u0 & 7) * 16 + ((u0 >> 3) & 15) : u0;
        const int kv = u >> 7, b = (u >> 4) & 7, g = (u >> 2) & 3, nt = u & 3;
        const int n = nt * 32 + r;
        const bf16_t* w1t = p.w1t + (size_t)(li * 2 + kv) * 64 * 2048;
        const bf16_t* w2t = p.w2t + (size_t)(li * 2 + kv) * 64 * 64;
        const float* c1 = p.c1 + (li * 2 + kv) * 64;
        const int colb = 1024 + kv * 256 + g * 64;
        f32x16 hacc[2];
#pragma unroll
        for (int q = 0; q < 16; ++q) { hacc[0][q] = 0.f; hacc[1][q] = 0.f; }
        for (int l = 4 * wid; l < 4 * wid + 4; ++l) {
            int tok = 16 * n + l; if (tok > 2047) tok = 2047;
            const bf16_t* ar = p.proj + ((size_t)b * S_ + tok) * ODD_LD + colb + 8 * h;
#pragma unroll
            for (int ks = 0; ks < 4; ++ks) {
                const bf16x8 bfrag = ld8(ar + 16 * ks);
#pragma unroll
                for (int ct = 0; ct < 2; ++ct) {
                    const bf16x8 afrag = ld8(w1t + (size_t)(32 * ct + swap23(r)) * 2048 + l * 64 + 16 * ks + 8 * h);
                    hacc[ct] = mfma32(afrag, bfrag, hacc[ct]);
                }
            }
        }
        __syncthreads();
#pragma unroll
        for (int ct = 0; ct < 2; ++ct)
#pragma unroll
            for (int q = 0; q < 16; ++q) part[((wid * 2 + ct) * 16 + q) * 64 + lane] = hacc[ct][q];
        __syncthreads();
        if (wid != 0) continue;
#pragma unroll
        for (int q = 0; q < 16; ++q) { hacc[0][q] = 0.f; hacc[1][q] = 0.f; }
#pragma unroll 1
        for (int w = 0; w < 8; ++w) {
#pragma unroll
            for (int ct = 0; ct < 2; ++ct)
#pragma unroll
                for (int q = 0; q < 16; ++q) hacc[ct][q] += part[((w * 2 + ct) * 16 + q) * 64 + lane];
        }
        union { bf16x8 v; unsigned uu[4]; } hf[2][2];
#pragma unroll
        for (int ct = 0; ct < 2; ++ct)
#pragma unroll
            for (int ks = 0; ks < 2; ++ks)
#pragma unroll
                for (int q = 0; q < 4; ++q) {
                    const int i0 = 8 * ks + 2 * q, cA = 32 * ct + koffs(i0, h), cB = 32 * ct + koffs(i0 + 1, h);
                    hf[ct][ks].uu[q] = cvt_pk_bf16(gelu_tanh(hacc[ct][i0] + c1[cA]), gelu_tanh(hacc[ct][i0 + 1] + c1[cB]));
                }
        f32x16 oacc[2];
#pragma unroll
        for (int q = 0; q < 16; ++q) { oacc[0][q] = 0.f; oacc[1][q] = 0.f; }
#pragma unroll
        for (int et = 0; et < 2; ++et)
#pragma unroll
            for (int ct = 0; ct < 2; ++ct)
#pragma unroll
                for (int ks = 0; ks < 2; ++ks) {
                    const bf16x8 afrag = ld8(w2t + (size_t)(32 * et + r) * 64 + 32 * ct + 16 * ks + 8 * h);
                    oacc[et] = mfma32(afrag, hf[ct][ks].v, oacc[et]);
                }
        if (kv == 0) {
            float ss = 0.f;
#pragma unroll
            for (int q = 0; q < 16; ++q) ss += oacc[0][q] * oacc[0][q] + oacc[1][q] * oacc[1][q];
            ss += __shfl_xor(ss, 32);
            const float rs = rsqrtf(ss * (1.f / 64.f) + 1e-6f);
            bf16_t* dst = p.kc + (size_t)(b * 4 + g) * 128 * 64;
            const float* kg = p.o_k_g + (size_t)(li * 3) * 64;
#pragma unroll
            for (int et = 0; et < 2; ++et)
#pragma unroll
                for (int g4 = 0; g4 < 4; ++g4) {
                    const int e = 32 * et + 8 * g4 + 4 * h;
                    u32x2 w; w.x = cvt_pk_bf16(oacc[et][4 * g4] * rs * kg[e], oacc[et][4 * g4 + 1] * rs * kg[e + 1]); w.y = cvt_pk_bf16(oacc[et][4 * g4 + 2] * rs * kg[e + 2], oacc[et][4 * g4 + 3] * rs * kg[e + 3]);
                    *(u32x2*)(dst + ktile_elem(n, e)) = w;
                }
        } else {
            bf16_t* dst = p.vcT + (size_t)(b * 4 + g) * 64 * 128;
#pragma unroll
            for (int et = 0; et < 2; ++et)
#pragma unroll
                for (int q = 0; q < 16; ++q) dst[vtile_elem(n, 32 * et + rowmap(q, h))] = f_to_bf(oacc[et][q]);
        }
    }
}

__device__ __forceinline__ int rel_bucket_dev(int n) {
    if (n < 16) return n;
    const int thr[15] = {19, 21, 24, 27, 31, 35, 40, 46, 52, 59, 67, 77, 87, 99, 113};
    int bk = 16;
#pragma unroll
    for (int k = 0; k < 15; ++k) bk += (n >= thr[k]) ? 1 : 0;
    return bk;
}
__device__ __forceinline__ void phase_nsa(const P& p, int layer, char* lds, int wv) {
    const int tid = opaque_tid(wv), lane = tid & 63, wid = __builtin_amdgcn_readfirstlane(tid >> 6), li = layer >> 1;
#define NSA_LANE() int lo_ = lane; asm volatile("" : "+v"(lo_)); const int r = lo_ & 31, h = lo_ >> 5; const int tq = q0 + r; const size_t t = (size_t)b * S_ + tq; (void)h; (void)t
    float* lut = (float*)lds;
    float* GS = (float*)(lds + 2048);
    float* LI = (float*)(lds + 2048 + 8 * 2 * 32 * 33 * 4);
    float* myG = GS + wid * 2 * 32 * 33; float* myL = myG + 32 * 33;
    const int j = wid & 3, usel = wid >> 2;
    float kgm = fmaxf(fabsf(p.o_k_g[(li * 3) * 64 + lane]), fmaxf(fabsf(p.o_k_g[(li * 3 + 1) * 64 + lane]), fabsf(p.o_k_g[(li * 3 + 2) * 64 + lane])));
    float tbm = 0.f;
#pragma unroll
    for (int q = 0; q < 8; ++q) tbm = fmaxf(tbm, fabsf(p.rel_table[q * 64 + lane]));
    const float M2 = (8.f * wave_max(fabsf(p.o_q_g[li * 64 + lane])) * wave_max(kgm) + wave_max(tbm)) * LOG2E;
    const float c1 = 0.125f * LOG2E;
    for (int bu = blockIdx.x; bu < 1024; bu += gridDim.x) {
        int bg, pp;
        if (gridDim.x == 256) {
            const int rnd = bu >> 8, xg = blockIdx.x & 7, i = blockIdx.x >> 3, i2 = (i + 16) & 31;
            bg = xg * 4 + rnd; pp = (rnd == 0) ? i : (rnd == 1) ? (31 - i) : (rnd == 2) ? i2 : (31 - i2);
        } else {
            const int rnd = (bu / 256) & 3, k = bu % 256, i8 = k & 7; bg = k >> 3;
            pp = (rnd == 0) ? i8 : (rnd == 1) ? (15 - i8) : (rnd == 2) ? (16 + i8) : (31 - i8);
        }
        const int b = bg >> 2, g = bg & 3;
        __syncthreads();
        { const int jj = tid >> 7, dist = tid & 127; lut[tid] = p.rel_table[rel_bucket_dev(dist) * 16 + g * 4 + jj] * LOG2E - M2; }
        __syncthreads();
        const float* mylut = lut + j * 128; const float b31 = mylut[127];
        const int qt = 2 * pp + usel, q0 = qt * 32;
        const int head = g * 4 + j;
        bf16x8 qf[4];
        unsigned ocp[16];
        unsigned selmask;
        {
        NSA_LANE();
        const int rb = r * 33;
#pragma unroll
        for (int ks = 0; ks < 4; ++ks) qf[ks] = bld8(mk_rsrc(p.proj, (unsigned)((size_t)T_ * ODD_LD * 2)), (unsigned)(t * ODD_LD + head * 64 + 8 * h) * 2u, 32 * ks);
        const rsrc_t rsKc = mk_rsrc(p.kc, (unsigned)(B_ * 4 * 128 * 64 * 2)), rsVc = mk_rsrc(p.vcT, (unsigned)(B_ * 4 * 64 * 128 * 2));
        const unsigned lo16 = (unsigned)lo_ * 16u;
        const unsigned kcb = (unsigned)((b * 4 + g) * 128 * 64 * 2), vcb = kcb;
        const int nkt = (q0 >> 9) + 1;
        AccF ac; accf_init(ac);
#pragma unroll
        for (int m = 0; m < 32; ++m) { if ((m >> 1 & 1) == h) { myG[rb + m] = 0.f; myL[rb + m] = 0.f; } }
#pragma unroll 1
        for (int kt = 0; kt < nkt; ++kt) {
            KF kf_; VF vf_;
            k_load(kf_, rsKc, lo16, kcb + (unsigned)kt * 4096u);
            v_load(vf_, rsVc, lo16, vcb + (unsigned)kt * 4096u);
            const f32x16 s = kv_scores(kf_, qf);
            float pv[16];
            int dbase = tq - 31 - 512 * kt - 128 * h; asm volatile("" : "+v"(dbase));
#pragma unroll
            for (int q = 0; q < 16; ++q) {
                const int dist = dbase - 16 * kofc(q);
                const float e = __builtin_amdgcn_exp2f(fmaf(s[q], c1, mylut[min(max(dist, 0), 127)]));
                pv[q] = (dist >= 0) ? e : 0.f;
            }
            if (kt == 3 && h == 1) pv[15] = 0.f;
#pragma unroll
            for (int gq = 0; gq < 4; ++gq) {
                const int m = 8 * kt + 2 * h + (gq & 1) + 4 * (gq >> 1);
                myG[rb + m] = pv[4 * gq] + pv[4 * gq + 1] + pv[4 * gq + 2] + pv[4 * gq + 3];
                myL[rb + m] = pv[4 * gq + 3];
            }
            kv_update_fixed(ac, pv, vf_);
        }
        const rsrc_t rsG = mk_rsrc(p.gates, (unsigned)((size_t)T_ * 48 * 4)); const unsigned gto = (unsigned)(t * 48 + (g * 4 + j) * 3) * 4u;
        { const float lc = ac.l + __shfl_xor(ac.l, 32); const float linv = (lc > 0.f) ? 1.f / lc : 0.f;
          if (h == 0) LI[wid * 32 + r] = linv;
          const float gc = __uint_as_float(__builtin_amdgcn_raw_buffer_load_b32(rsG, gto, 0, 0)) * linv;
#pragma unroll
          for (int q = 0; q < 8; ++q) { ocp[q] = cvt_pk_bf16(ac.o[0][2 * q] * gc, ac.o[0][2 * q + 1] * gc); ocp[8 + q] = cvt_pk_bf16(ac.o[1][2 * q] * gc, ac.o[1][2 * q + 1] * gc); } }
        }
        __syncthreads();
        {
        NSA_LANE();
        const int rb = r * 33;
            const float* G0 = GS + (usel * 4) * 2 * 32 * 33;
            float li4[4];
#pragma unroll
            for (int jj = 0; jj < 4; ++jj) li4[jj] = LI[(usel * 4 + jj) * 32 + r];
            float imp[32];
            const int cur = tq >> 6;
#pragma unroll
            for (int m = 0; m < 32; ++m) {
                float v = 0.f;
#pragma unroll
                for (int jj = 0; jj < 4; ++jj) { const float* Gj = G0 + jj * 2 * 32 * 33; float gl = Gj[rb + m]; if (m > 0) gl += Gj[32 * 33 + rb + m - 1]; v += li4[jj] * gl; }
                v = (m == 0 || m == cur || m == cur - 1) ? 1e6f : ((m <= cur) ? v : -1.f);
                imp[m] = __uint_as_float((__float_as_uint(v) & ~31u) | (unsigned)(31 - m));
            }
            unsigned mym = 0;
            const unsigned hm = (unsigned)(-h);
#pragma unroll
            for (int mi = 0; mi < 16; ++mi) {
                const float mine = __uint_as_float((__float_as_uint(imp[mi]) & ~hm) | (__float_as_uint(imp[16 + mi]) & hm));
                int rank = 0;
#pragma unroll
                for (int m2 = 0; m2 < 32; ++m2) rank += (imp[m2] > mine) ? 1 : 0;
                unsigned bit = (rank < 16 && mine >= 0.f) ? 1u : 0u; asm volatile("" : "+v"(bit));
                mym |= bit << mi;
            }
            mym <<= 16 * h;
            selmask = mym | (unsigned)__shfl_xor((int)mym, 32);
        }
        const rsrc_t rsK = mk_rsrc(p.kt, (unsigned)((size_t)T_ * 512 * 2)), rsV = mk_rsrc(p.vT, (unsigned)((size_t)T_ * 512 * 2));
        const unsigned ksb = (unsigned)((size_t)(b * 4 + g) * 64 * S_ * 2), vsb = ksb;
        {
        NSA_LANE();
        const unsigned lo16 = (unsigned)lo_ * 16u;
        const rsrc_t rsG = mk_rsrc(p.gates, (unsigned)((size_t)T_ * 48 * 4)); const unsigned gto = (unsigned)(t * 48 + (g * 4 + j) * 3) * 4u;
        AccF as; accf_init(as);
        {
            unsigned long long vis;
            { unsigned long long x = (unsigned long long)wave_or(selmask);
              x = (x | (x << 16)) & 0x0000FFFF0000FFFFull; x = (x | (x << 8)) & 0x00FF00FF00FF00FFull; x = (x | (x << 4)) & 0x0F0F0F0F0F0F0F0Full;
              x = (x | (x << 2)) & 0x3333333333333333ull; x = (x | (x << 1)) & 0x5555555555555555ull; vis = x | (x << 1);
              if (qt < 63) vis &= ((1ull << (qt + 1)) - 1ull); }
            KF cur, nxt; VF vcur;
            int tile = __builtin_ctzll(vis); vis &= vis - 1ull;
            k_load(cur, rsK, lo16, ksb + (unsigned)tile * 4096u);
#pragma unroll 1
            for (;;) {
                const bool more = vis != 0ull; int ntile = 0;
                v_load(vcur, rsV, lo16, vsb + (unsigned)tile * 4096u);
                ntile = more ? (int)__builtin_ctzll(vis) : tile; vis &= vis - 1ull;
                k_load(nxt, rsK, lo16, ksb + (unsigned)ntile * 4096u);
                const int k0 = tile * 32;
                const f32x16 s = kv_scores(cur, qf);
                const bool on = (selmask >> (tile >> 1)) & 1u;
                float pv[16];
                if (q0 - (k0 + 31) >= 113) {
#pragma unroll
                    for (int q = 0; q < 16; ++q) pv[q] = on ? __builtin_amdgcn_exp2f(fmaf(s[q], c1, b31)) : 0.f;
                } else {
                    int dbase = tq - k0 - 8 * h; asm volatile("" : "+v"(dbase));
#pragma unroll
                    for (int q = 0; q < 16; ++q) {
                        const int dist = dbase - kofc(q);
                        const float e = __builtin_amdgcn_exp2f(fmaf(s[q], c1, mylut[min(max(dist, 0), 127)]));
                        pv[q] = (on && dist >= 0) ? e : 0.f;
                    }
                }
                kv_update_fixed(as, pv, vcur);
                if (!more) break;
                cur = nxt; tile = ntile;
            }
        }
        { const float ls = as.l + __shfl_xor(as.l, 32); const float gs = __uint_as_float(__builtin_amdgcn_raw_buffer_load_b32(rsG, gto, 4, 0)) / ls;
#pragma unroll
          for (int q = 0; q < 8; ++q) { ocp[q] = cvt_pk_bf16(bf_lo(ocp[q]) + gs * as.o[0][2 * q], bf_hi(ocp[q]) + gs * as.o[0][2 * q + 1]); ocp[8 + q] = cvt_pk_bf16(bf_lo(ocp[8 + q]) + gs * as.o[1][2 * q], bf_hi(ocp[8 + q]) + gs * as.o[1][2 * q + 1]); } }
        }
        {
        NSA_LANE();
        const unsigned lo16 = (unsigned)lo_ * 16u;
        const rsrc_t rsG = mk_rsrc(p.gates, (unsigned)((size_t)T_ * 48 * 4)); const unsigned gto = (unsigned)(t * 48 + (g * 4 + j) * 3) * 4u;
        const unsigned kwb = (unsigned)(((size_t)B_ * 4 * 64 * S_ + (size_t)(b * 4 + g) * 64 * S_) * 2), vwb = kwb;
        AccF aw; accf_init(aw);
        {
            KF cur, nxt; VF vcur;
            const int kstart = (q0 >= 512 ? q0 - 512 : 0);
            k_load(cur, rsK, lo16, kwb + (unsigned)kstart * 128u);
#pragma unroll 1
            for (int k0 = kstart; k0 <= q0; k0 += 32) {
                v_load(vcur, rsV, lo16, vwb + (unsigned)k0 * 128u);
                k_load(nxt, rsK, lo16, kwb + (unsigned)((k0 + 32 <= q0) ? k0 + 32 : k0) * 128u);
                const f32x16 s = kv_scores(cur, qf);
                float pv[16];
                if (q0 - (k0 + 31) >= 113 && q0 + 31 - k0 < 512) {
#pragma unroll
                    for (int q = 0; q < 16; ++q) pv[q] = __builtin_amdgcn_exp2f(fmaf(s[q], c1, b31));
                } else {
                    int dbase = tq - k0 - 8 * h; asm volatile("" : "+v"(dbase));
#pragma unroll
                    for (int q = 0; q < 16; ++q) {
                        const int dist = dbase - kofc(q);
                        const float e = __builtin_amdgcn_exp2f(fmaf(s[q], c1, mylut[min(max(dist, 0), 127)]));
                        pv[q] = (dist >= 0 && dist < 512) ? e : 0.f;
                    }
                }
                kv_update_fixed(aw, pv, vcur);
                cur = nxt;
            }
        }
        const float lw = aw.l + __shfl_xor(aw.l, 32);
        const float gwv = __uint_as_float(__builtin_amdgcn_raw_buffer_load_b32(rsG, gto, 8, 0)) / lw;
        const rsrc_t rsC = mk_rsrc(p.cat, (unsigned)((size_t)T_ * D_ * 2)); const unsigned dsto = (unsigned)(t * D_ + head * 64) * 2u;
#pragma unroll
        for (int db = 0; db < 2; ++db)
#pragma unroll
            for (int g4 = 0; g4 < 4; ++g4) {
                float o[4];
#pragma unroll
                for (int q = 0; q < 4; ++q) { const unsigned pw = ocp[8 * db + 2 * g4 + (q >> 1)]; o[q] = ((q & 1) ? bf_hi(pw) : bf_lo(pw)) + gwv * aw.o[db][4 * g4 + q]; }
                u32x2 w; w.x = cvt_pk_bf16(o[0], o[1]); w.y = cvt_pk_bf16(o[2], o[3]);
                __builtin_amdgcn_raw_buffer_store_b64(w, rsC, dsto + (unsigned)(32 * db + 8 * g4 + 4 * h) * 2u, 0, 0);
            }
        }
    }
#undef NSA_LANE
}

#define SN_HD __device__ __forceinline__
template <int N> SN_HD void sn_sort_desc(float (&v)[N]) {
#pragma unroll
    for (int k = 2; k <= N; k <<= 1)
#pragma unroll
        for (int j = k >> 1; j > 0; j >>= 1)
#pragma unroll
            for (int i = 0; i < N; ++i) { const int l = i ^ j; if (l > i) { const bool desc = ((i & k) == 0); const float a = v[i], b = v[l], hi = fmaxf(a, b), lo = fminf(a, b); v[i] = desc ? hi : lo; v[l] = desc ? lo : hi; } }
}
template <int N> SN_HD void sn_merge_desc(float (&v)[N]) {
#pragma unroll
    for (int j = N >> 1; j > 0; j >>= 1)
#pragma unroll
        for (int i = 0; i < N; ++i) if ((i & j) == 0) { const float a = v[i], b = v[i + j]; v[i] = fmaxf(a, b); v[i + j] = fminf(a, b); }
}
SN_HD void sn_top16_merge(float (&x)[16], const float (&y)[16]) {
#pragma unroll
    for (int i = 0; i < 16; ++i) x[i] = fmaxf(x[i], y[15 - i]);
    sn_merge_desc<16>(x);
}
SN_HD void sn_top16_of64(float (&v)[64], float (&out)[16]) {
    float g[4][16];
#pragma unroll
    for (int q = 0; q < 4; ++q) {
#pragma unroll
        for (int i = 0; i < 16; ++i) g[q][i] = v[16 * q + i];
        sn_sort_desc<16>(g[q]);
    }
    sn_top16_merge(g[0], g[1]); sn_top16_merge(g[2], g[3]); sn_top16_merge(g[0], g[2]);
#pragma unroll
    for (int i = 0; i < 16; ++i) out[i] = g[0][i];
}

__device__ __forceinline__ float sel_h(float a, float b, unsigned hm) { return __uint_as_float((__float_as_uint(a) & ~hm) | (__float_as_uint(b) & hm)); }
__device__ __forceinline__ void phase_peer_sel(const P& p, int layer, char* lds, int wv) {
    const int tid = opaque_tid(wv), lane = tid & 63, wid = __builtin_amdgcn_readfirstlane(tid >> 6), r = lane & 31, h = lane >> 5;
    const unsigned hm = (unsigned)(-h);
    constexpr int CI[50] = {0, 0, 0, 0, 0, 0, 0, 0, 0, 0, 0, 0, 0, 0, 0, 0, 1, 1, 1, 1, 1, 1, 1, 1, 2, 2, 2, 2, 2, 3, 3, 3, 3, 4, 4, 4, 5, 5, 6, 6, 7, 7, 8, 9, 10, 11, 12, 13, 14, 15};
    constexpr int CJ[50] = {0, 1, 2, 3, 4, 5, 6, 7, 8, 9, 10, 11, 12, 13, 14, 15, 0, 1, 2, 3, 4, 5, 6, 7, 0, 1, 2, 3, 4, 0, 1, 2, 3, 0, 1, 2, 0, 1, 0, 1, 0, 1, 0, 0, 0, 0, 0, 0, 0, 0};
    unsigned char* ixl = (unsigned char*)lds + 36864 + wid * 1024 + r * 32;
    __syncthreads();
    for (int i = tid; i < 256 * 8; i += NTHR) { const int row = i >> 3, ch = i & 7; *(u32x4*)(lds + row * 144 + ch * 16) = *(const u32x4*)(p.keys16 + (size_t)layer * 2 * 128 * 64 + row * 64 + ch * 8); }
    __syncthreads();
    const bf16_t* Q16 = (const bf16_t*)p.qp;
    const int nw = gridDim.x * NWV;
    const bool aff = (gridDim.x == 256);
    const int task0 = aff ? 512 * (int)(blockIdx.x & 7) + (int)(blockIdx.x >> 3) * NWV + wid : (int)blockIdx.x * NWV + wid, tstep = aff ? 256 : nw, tend = aff ? 512 * (int)(blockIdx.x & 7) + 512 : T_ * 8 / 32;
    for (int task = task0; task < tend; task += tstep) {
        const int t = task * 4 + (r >> 3), hd = r & 7;
        int kro = r * 144 + 16 * h; asm volatile("" : "+v"(kro));
        float top[2][16];
#pragma unroll
        for (int pp = 0; pp < 2; ++pp) {
            const bf16_t* qrow = Q16 + (size_t)t * D_ + hd * 128 + pp * 64 + 8 * h;
            bf16x8 qf[4];
#pragma unroll
            for (int ks = 0; ks < 4; ++ks) qf[ks] = ld8(qrow + 16 * ks);
            float z[16], o[16];
#pragma unroll
            for (int kt = 0; kt < 4; ++kt) {
                f32x16 s;
#pragma unroll
                for (int q = 0; q < 16; ++q) s[q] = 0.f;
#pragma unroll
                for (int ks = 0; ks < 4; ++ks) s = mfma32(*(const bf16x8*)(lds + kro + (pp * 128 + 32 * kt) * 144 + 32 * ks), qf[ks], s);
#pragma unroll
                for (int q = 0; q < 16; ++q) o[q] = __uint_as_float((__float_as_uint(s[q]) & ~127u) | (unsigned)(32 * kt + rowmap(q, h)));
                sn_sort_desc<16>(o);
                if (kt == 0) {
#pragma unroll
                    for (int i = 0; i < 16; ++i) z[i] = o[i];
                } else sn_top16_merge(z, o);
                __builtin_amdgcn_sched_barrier(0);
            }
#pragma unroll
            for (int i = 0; i < 16; ++i) o[i] = __shfl_xor(z[i], 32);
            sn_top16_merge(z, o);
#pragma unroll
            for (int i = 0; i < 16; ++i) top[pp][i] = z[i];
            __builtin_amdgcn_sched_barrier(0);
        }
        {
            unsigned w[4];
#pragma unroll
            for (int q = 0; q < 4; ++q) {
                unsigned acc = 0;
#pragma unroll
                for (int b4 = 0; b4 < 4; ++b4) acc |= (__float_as_uint(sel_h(top[0][4 * q + b4], top[1][4 * q + b4], hm)) & 127u) << (8 * b4);
                w[q] = acc;
            }
            *(u32x4*)(ixl + 16 * h) = (u32x4){w[0], w[1], w[2], w[3]};
        }
        float c[32];
#pragma unroll
        for (int k = 0; k < 25; ++k) {
            const float s0 = top[0][CI[k]] + top[1][CJ[k]], s1 = top[0][CI[25 + k]] + top[1][CJ[25 + k]];
            const unsigned code = h ? (unsigned)((CI[25 + k] << 4) | CJ[25 + k]) : (unsigned)((CI[k] << 4) | CJ[k]);
            c[k] = __uint_as_float((__float_as_uint(sel_h(s0, s1, hm)) & ~255u) | code);
        }
#pragma unroll
        for (int k = 25; k < 32; ++k) c[k] = -INFINITY;
        float fa[16], fb[16];
#pragma unroll
        for (int i = 0; i < 16; ++i) { fa[i] = c[i]; fb[i] = c[16 + i]; }
        __builtin_amdgcn_sched_barrier(0);
        sn_sort_desc<16>(fa); __builtin_amdgcn_sched_barrier(0); sn_sort_desc<16>(fb); __builtin_amdgcn_sched_barrier(0); sn_top16_merge(fa, fb);
#pragma unroll
        for (int i = 0; i < 16; ++i) fb[i] = __shfl_xor(fa[i], 32);
        sn_top16_merge(fa, fb);
        float den = 0.f, ex[16];
#pragma unroll
        for (int i = 0; i < 16; ++i) { ex[i] = __expf(fa[i] - fa[0]); den += ex[i]; }
        const float rden = 1.f / den;
        __builtin_amdgcn_wave_barrier();
        int eo[8]; float go[8];
#pragma unroll
        for (int kk = 0; kk < 8; ++kk) {
            const unsigned code = __float_as_uint(sel_h(fa[kk], fa[8 + kk], hm)) & 255u;
            const unsigned ia = ixl[code >> 4], ib = ixl[16 + (code & 15u)];
            eo[kk] = (int)(ia * 128u + ib); go[kk] = sel_h(ex[kk], ex[8 + kk], hm) * rden;
        }
        const size_t ob = ((size_t)t * 8 + hd) * 16 + 8 * h;
        *(u32x4*)(p.seli + ob) = (u32x4){(unsigned)eo[0], (unsigned)eo[1], (unsigned)eo[2], (unsigned)eo[3]}; *(u32x4*)(p.seli + ob + 4) = (u32x4){(unsigned)eo[4], (unsigned)eo[5], (unsigned)eo[6], (unsigned)eo[7]};
        *(f32x4*)(p.selg + ob) = (f32x4){go[0], go[1], go[2], go[3]}; *(f32x4*)(p.selg + ob + 4) = (f32x4){go[4], go[5], go[6], go[7]};
        __builtin_amdgcn_wave_barrier();
    }
}

__device__ __forceinline__ float dpp_xor1(float v) { return DPPF(v, v, 0xB1, 0xf); }
template <int I, int N, class F> __device__ __forceinline__ void static_for(F&& f) { if constexpr (I < N) { f(std::integral_constant<int, I>{}); static_for<I + 1, N>(f); } }
template <int I> __device__ __forceinline__ int row_bcast(int x) { return __builtin_amdgcn_update_dpp(0, x, 0x150 + I, 0xf, 0xf, true); }
struct PaRaw { int i0, i1; float g0, g1; u32x3 h0, h1; };
__device__ __forceinline__ u32x3 pack6x16(u32x4 b) {
    unsigned c[16];
#pragma unroll
    for (int q = 0; q < 4; ++q) { c[4 * q] = b[q] & 63u; c[4 * q + 1] = (b[q] >> 8) & 63u; c[4 * q + 2] = (b[q] >> 16) & 63u; c[4 * q + 3] = (b[q] >> 24) & 63u; }
    u32x3 d;
    d.x = c[0] | (c[1] << 6) | (c[2] << 12) | (c[3] << 18) | (c[4] << 24) | (c[5] << 30);
    d.y = (c[5] >> 2) | (c[6] << 4) | (c[7] << 10) | (c[8] << 16) | (c[9] << 22) | (c[10] << 28);
    d.z = (c[10] >> 4) | (c[11] << 2) | (c[12] << 8) | (c[13] << 14) | (c[14] << 20) | (c[15] << 26);
    return d;
}
__device__ __forceinline__ long lo64(u32x4 v) { return (long)(((unsigned long)v.y << 32) | v.x); }
__device__ __forceinline__ long hi64(u32x4 v) { return (long)(((unsigned long)v.w << 32) | v.z); }
__device__ __forceinline__ float dpp_xor2(float v) { return DPPF(v, v, 0x4E, 0xf); }
template <int GH = 0>
__device__ __forceinline__ void phase_peer_a(const P& p, int layer, char* lds, int wv) {
    const int tid = opaque_tid(wv), lane = tid & 63, wid = __builtin_amdgcn_readfirstlane(tid >> 6);
    const int wig = blockIdx.x * NWV + wid, nwg = gridDim.x * NWV;
    if (wig >= T_) return;
    const rsrc_t rsU = mk_rsrc(p.u8 + (size_t)layer * 16384 * 768, 16384u * 768u);
    const rsrc_t rsI = mk_rsrc(p.seli, (unsigned)((size_t)T_ * 128 * 4)), rsG = mk_rsrc(p.selg, (unsigned)((size_t)T_ * 128 * 4));
    const rsrc_t rsH = mk_rsrc(p.h8, (unsigned)((size_t)T_ * 1536)), rsS = mk_rsrc(p.hinv, (unsigned)((size_t)T_ * 4));
    unsigned short* wq = GH ? (unsigned short*)p.proj : (unsigned short*)p.wexp; float* winv = GH ? (float*)p.proj + (size_t)T_ * 64 : p.winv;
    const unsigned lo16 = (unsigned)lane * 16u;
    const bool aff = (gridDim.x == 256);
    const int tb0 = aff ? 2048 * (int)(blockIdx.x & 7) + (int)(blockIdx.x >> 3) * NWV + wid : wig, tbs = aff ? 256 : nwg;
    const int ntok = aff ? 8 : (T_ - 1 - wig) / nwg + 1;
    auto tok_at = [&](int k) { return tb0 + ((k < ntok) ? k : 0) * tbs; };
    auto raw_load = [&](PaRaw& r, int t) {
        r.i0 = (int)__builtin_amdgcn_raw_buffer_load_b32(rsI, (unsigned)lane * 4u, (unsigned)__builtin_amdgcn_readfirstlane(t * 512), 0);
        r.i1 = (int)__builtin_amdgcn_raw_buffer_load_b32(rsI, (unsigned)lane * 4u, (unsigned)__builtin_amdgcn_readfirstlane(t * 512 + 256), 0);
        r.g0 = __uint_as_float(__builtin_amdgcn_raw_buffer_load_b32(rsG, (unsigned)lane * 4u, (unsigned)__builtin_amdgcn_readfirstlane(t * 512), 0));
        r.g1 = __uint_as_float(__builtin_amdgcn_raw_buffer_load_b32(rsG, (unsigned)lane * 4u, (unsigned)__builtin_amdgcn_readfirstlane(t * 512 + 256), 0));
        r.h0 = __builtin_amdgcn_raw_buffer_load_b96(rsH, (unsigned)lane * 24u, (unsigned)__builtin_amdgcn_readfirstlane(t * 1536), 0);
        r.h1 = __builtin_amdgcn_raw_buffer_load_b96(rsH, (unsigned)lane * 24u + 12u, (unsigned)__builtin_amdgcn_readfirstlane(t * 1536), 0); };
    const bool ond = ((lane & 15) >> 2) == (lane >> 4);
    const float dw0 = (ond && (lane & 3) == 0) ? 1.f : 0.f, dw1 = (ond && (lane & 3) == 1) ? 1.f : 0.f, dw2 = (ond && (lane & 3) == 2) ? 1.f : 0.f, dw3 = (ond && (lane & 3) == 3) ? 1.f : 0.f;
    const bool b0 = lane & 1, b1 = lane & 2, b2 = lane & 4;
    u32x3 buf[4][8]; const unsigned lo12 = (unsigned)lane * 12u;
    constexpr int LA = 2;
    PaRaw RC, RN;
    raw_load(RC, tok_at(0));
    static_for<0, LA>([&](auto sc_) { constexpr int q = decltype(sc_)::value;
#pragma unroll
        for (int e = 0; e < 8; ++e) { int ex = rdlanei(q < 8 ? RC.i0 : RC.i1, (8 * q + e) & 63); if (GH) ex &= 255; buf[q][e] = __builtin_amdgcn_raw_buffer_load_b96(rsU, lo12, (unsigned)ex * 768u, 0); } });
#pragma unroll 1
    for (int kt = 0; kt < ntok; ++kt) {
        const int t = tok_at(kt);
        raw_load(RN, tok_at(kt + 1));
        const float hinv = __uint_as_float(__builtin_amdgcn_raw_buffer_load_b32(rsS, 0u, (unsigned)__builtin_amdgcn_readfirstlane(t * 4), 0));
        const float inv = hinv * (1.f / U6_SCALE);
        float R = 0.f, W0 = 0.f;
        const v8i32 hB = {(int)RC.h0.x, (int)RC.h0.y, (int)RC.h0.z, (int)RC.h1.x, (int)RC.h1.y, (int)RC.h1.z, 0, 0};
        static_for<0, 16>([&](auto sc_) { constexpr int s = decltype(sc_)::value;
            {
                constexpr int q = (s + LA) & 15; constexpr bool nx = (s + LA) >= 16;
#pragma unroll
                for (int e = 0; e < 8; ++e) { int ex = rdlanei(nx ? (q < 8 ? RN.i0 : RN.i1) : (q < 8 ? RC.i0 : RC.i1), (8 * q + e) & 63); if (GH) ex &= 255;
                    buf[(s + LA) & 3][e] = __builtin_amdgcn_raw_buffer_load_b96(rsU, lo12, (unsigned)ex * 768u, 0); }
            }
            float d[8]; f32x4 acc[8];
#pragma unroll
            for (int e = 0; e < 8; ++e) {
                const u32x3 r = buf[s & 3][e];
                const v8i32 A = {(int)r.x, (int)r.y, (int)r.z, (int)r.x, (int)r.y, (int)r.z, 0, 0};
                acc[e] = __builtin_amdgcn_mfma_scale_f32_16x16x128_f8f6f4(A, hB, (f32x4){0.f, 0.f, 0.f, 0.f}, 2, 2, 0, 0x7f7f7f7f, 0, 0x7f7f7f7f);
            }
#pragma unroll
            for (int e = 0; e < 8; ++e) d[e] = acc[e][0] * dw0 + acc[e][1] * dw1 + acc[e][2] * dw2 + acc[e][3] * dw3;
            float n1[4], n2[2];
#pragma unroll
            for (int i = 0; i < 4; ++i) { const float a = b0 ? d[2 * i + 1] : d[2 * i], b = b0 ? d[2 * i] : d[2 * i + 1]; n1[i] = a + dpp_xor1(b); }
#pragma unroll
            for (int i = 0; i < 2; ++i) { const float a = b1 ? n1[2 * i + 1] : n1[2 * i], b = b1 ? n1[2 * i] : n1[2 * i + 1]; n2[i] = a + dpp_xor2(b); }
            float sm; { const float a = b2 ? n2[1] : n2[0], b = b2 ? n2[0] : n2[1]; sm = a + __int_as_float(__builtin_amdgcn_ds_swizzle(__float_as_int(b), 0x101f)); }
            sm += DPPF(sm, sm, 0x128, 0xf);
            sm += __shfl_xor(sm, 16); sm += __shfl_xor(sm, 32);
            R = ((lane >> 3) == (s & 7)) ? sm : R;
            if constexpr (s == 7) W0 = RC.g0 * gelu_tanh(R * inv);
            if constexpr (s == 15) {
                const float W1 = RC.g1 * gelu_tanh(R * inv);
                const float am = wave_max(fmaxf(fmaxf(fabsf(W0), fabsf(W1)), 1e-30f)), sc = 7.5f / am;
                const float q0 = W0 * sc, q1 = W1 * sc;
                const unsigned h0c = enc_e2m3(q0), h1c = enc_e2m3(q1), l0c = enc_e2m3(q0 - dec_e2m3(h0c)), l1c = enc_e2m3(q1 - dec_e2m3(h1c));
                wq[(size_t)t * 128 + lane] = (unsigned short)(h0c | (l0c << 8));
                wq[(size_t)t * 128 + 64 + lane] = (unsigned short)(h1c | (l1c << 8));
                if (lane == 0) winv[t] = am * (1.f / 7.5f);
            }
        });
        RC = RN;
    }
}
#ifndef PB6_TERMS
#define PB6_TERMS 1
#endif
template <int GH = 0>
__device__ __forceinline__ void phase_peer_b6(const P& p, int layer, int wv) {
    const int tid = opaque_tid(wv), lane = tid & 63, wid = __builtin_amdgcn_readfirstlane(tid >> 6);
    constexpr int CSB = 192, NPS = 4, NCLS = 2;
    const int wig = (blockIdx.x >> 3) * NWV + wid, nwg = (gridDim.x >> 3) * NWV;
    const int mm = lane & 15, kbb = lane >> 4, ps = kbb;
    const unsigned widC = (mm <= 10) ? 6u : 0u, s64 = (mm <= 10) ? 6u * (unsigned)mm : 0u;
    const unsigned off2 = (mm == 10) ? 4u : 0u, wid2 = (mm == 10) ? 2u : (mm >= 11 ? 6u : 0u), sA2 = (mm >= 11) ? 6u * (unsigned)mm - 64u : 0u;
    auto sel6 = [&](unsigned w, bool second, int& d0, int& d1, int& d2) {
        const unsigned long long x = (unsigned long long)__builtin_amdgcn_ubfe(w, second ? 8u : 0u, widC) << s64;
        d0 = (int)(unsigned)x; d1 = (int)(unsigned)(x >> 32); d2 = (int)(__builtin_amdgcn_ubfe(w, second ? off2 + 8u : off2, wid2) << sA2); };
    {
        const int xgp = (int)(blockIdx.x & 7), xs = xgp % 4, th = xgp / 4;
        const rsrc_t rsI = mk_rsrc(p.seli, (unsigned)((size_t)T_ * 128 * 4)), rsW = mk_rsrc(p.wexp, (unsigned)((size_t)T_ * 128 * 2)), rsS = mk_rsrc(p.winv, (unsigned)((size_t)T_ * 4));
        const rsrc_t rsVs = mk_rsrc(p.v8 + ((size_t)layer * 4 + xs) * 16384 * CSB, 16384u * (unsigned)CSB);
        const unsigned cco = (unsigned)mm * 12u;
        const int ntok = (T_ / NCLS - 1 - wig) / nwg + 1;
        if (wig >= T_ / NCLS) return;
        u32x3 va[16], vb[16]; f32x4 acc;
        struct BRaw { int i0, i1, w0, w1; float sv; };
        auto tok_at = [&](int k) { const int kk = (k < ntok) ? k : 0; return NCLS * (wig + kk * nwg) + th; };
        auto raw_load = [&](BRaw& r, int t) { r.i0 = (int)__builtin_amdgcn_raw_buffer_load_b32(rsI, (unsigned)lane * 4u, (unsigned)__builtin_amdgcn_readfirstlane(t * 512), 0);
            r.i1 = (int)__builtin_amdgcn_raw_buffer_load_b32(rsI, (unsigned)lane * 4u, (unsigned)__builtin_amdgcn_readfirstlane(t * 512 + 256), 0);
            r.w0 = (int)(unsigned short)__builtin_amdgcn_raw_buffer_load_b16(rsW, (unsigned)lane * 2u, (unsigned)__builtin_amdgcn_readfirstlane(t * 256), 0);
            r.w1 = (int)(unsigned short)__builtin_amdgcn_raw_buffer_load_b16(rsW, (unsigned)lane * 2u, (unsigned)__builtin_amdgcn_readfirstlane(t * 256 + 128), 0);
            r.sv = __uint_as_float(__builtin_amdgcn_raw_buffer_load_b32(rsS, 0u, (unsigned)__builtin_amdgcn_readfirstlane(t * 4), 0)); };
#define PB6_PREP(E_, W_, r_, bb) { const int sl_ = 4 * mm + ps; const int a_ = __shfl((bb) ? r_.i1 : r_.i0, sl_); E_ = (GH ? (a_ & 255) : a_) * CSB; W_ = __shfl((bb) ? r_.w1 : r_.w0, sl_); }
#define PB6_GATHER(v_, E_) static_for<0, 16>([&](auto ic_) { constexpr int i = decltype(ic_)::value; v_[i] = __builtin_amdgcn_raw_buffer_load_b96(rsVs, (unsigned)row_bcast<i>(E_) + cco, 0, 0); })
#define PB6_ACC(v_, W_) static_for<0, 8>([&](auto ic_) { constexpr int i = 2 * decltype(ic_)::value; const unsigned wa_ = (unsigned)row_bcast<i>(W_), wb_ = (unsigned)row_bcast<i + 1>(W_); \
            const v8i32 bv_ = {(int)v_[i].x, (int)v_[i].y, (int)v_[i].z, (int)v_[i + 1].x, (int)v_[i + 1].y, (int)v_[i + 1].z, 0, 0}; \
            { int h0_, h1_, h2_, h3_, h4_, h5_; sel6(wa_, false, h0_, h1_, h2_); sel6(wb_, false, h3_, h4_, h5_); const v8i32 ah_ = {h0_, h1_, h2_, h3_, h4_, h5_, 0, 0}; \
              acc = __builtin_amdgcn_mfma_scale_f32_16x16x128_f8f6f4(ah_, bv_, acc, 2, 2, 0, 0x7f7f7f7f, 0, 0x7f7f7f7f); } \
            if (PB6_TERMS == 2) { int l0_, l1_, l2_, l3_, l4_, l5_; sel6(wa_, true, l0_, l1_, l2_); sel6(wb_, true, l3_, l4_, l5_); const v8i32 al_ = {l0_, l1_, l2_, l3_, l4_, l5_, 0, 0}; \
              acc = __builtin_amdgcn_mfma_scale_f32_16x16x128_f8f6f4(al_, bv_, acc, 2, 2, 0, 0x7f7f7f7f, 0, 0x7f7f7f7f); } })
        BRaw RC, RN;
        raw_load(RC, tok_at(0)); raw_load(RN, tok_at(1));
        int Ea, Eb, Wa, Wb;
        PB6_PREP(Ea, Wa, RC, 0); PB6_GATHER(va, Ea);
        const int cL = 16 * mm + 4 * kbb;
        const rsrc_t rsO = mk_rsrc(GH ? (const void*)p.proj : (const void*)p.out, (unsigned)((size_t)T_ * D_ * 4)), rsM = mk_rsrc(p.mods, (unsigned)((size_t)4 * B_ * 6144 * 4));
        const unsigned cvo = (unsigned)(256 * xs + cL) * 4u;
#pragma unroll 1
        for (int kt = 0; kt < ntok; ++kt) {
            const int t = NCLS * (wig + kt * nwg) + th;
            const unsigned xoff = (unsigned)__builtin_amdgcn_readfirstlane(t * (D_ * 4)), goff = (unsigned)__builtin_amdgcn_readfirstlane(((layer * B_ + (t >> 11)) * 6144 + 5120) * 4);
            const f32x4 xa = __builtin_bit_cast(f32x4, __builtin_amdgcn_raw_buffer_load_b128(rsO, cvo, xoff, 0));
            const f32x4 ga = __builtin_bit_cast(f32x4, __builtin_amdgcn_raw_buffer_load_b128(rsM, cvo, goff, 0));
            acc = (f32x4){0.f, 0.f, 0.f, 0.f};
            PB6_PREP(Eb, Wb, RC, 1); PB6_GATHER(vb, Eb); PB6_ACC(va, Wa);
            PB6_PREP(Ea, Wa, RN, 0); PB6_GATHER(va, Ea);
            PB6_ACC(vb, Wb);
            const float ws = RC.sv * (1.f / V6_SCALE);
            RC = RN; raw_load(RN, tok_at(kt + 2));
            f32x4 oa;
#pragma unroll
            for (int q = 0; q < 4; ++q) oa[q] = xa[q] + ga[q] * (acc[q] * ws);
            __builtin_amdgcn_raw_buffer_store_b128(__builtin_bit_cast(u32x4, oa), rsO, cvo, xoff, 0);
        }
#undef PB6_PREP
#undef PB6_GATHER
#undef PB6_ACC
    }
}

#define XB_TMO      128
#define XB_XCNT(j)  (256  + 64 * (j))
#define XB_XSUB(j)  (1280 + 64 * (j))
#define XB_XGEN(j)  (2304 + 64 * (j))
#define XB_TOP      3328
#define XB_TOPGEN   3392
#define XCD_BAR_WORDS 3456
#define XB_SPIN_CAP (1u << 18)
#define LAS __attribute__((address_space(3)))

__device__ __forceinline__ unsigned xb_ld(unsigned* p)              { return __hip_atomic_load(p, __ATOMIC_RELAXED, __HIP_MEMORY_SCOPE_AGENT); }
__device__ __forceinline__ unsigned xb_add(unsigned* p, unsigned v) { return __hip_atomic_fetch_add(p, v, __ATOMIC_RELAXED, __HIP_MEMORY_SCOPE_AGENT); }
__device__ __forceinline__ unsigned xb_xcc_id() { return (unsigned)__builtin_amdgcn_s_getreg((3 << 11) | 20) & 0xFu; }
#define XB_SPIN(cond, bar) do { unsigned _sp = 0; while (cond) { __builtin_amdgcn_s_sleep(1); \
    if ((++_sp & 255u) == 0u) { if (xb_ld(&(bar)[XB_TMO])) break; if (_sp > XB_SPIN_CAP) { atomicAdd(&(bar)[XB_TMO], 1u); break; } } } } while (0)

struct XcdBarrier {
    unsigned* bar; unsigned x;
    volatile LAS unsigned* st;
};

__device__ __forceinline__ XcdBarrier xcd_barrier_post(unsigned* bar, volatile LAS unsigned* st) {
    XcdBarrier b; b.bar = bar; b.x = xb_xcc_id(); b.st = st;
    if (threadIdx.x == 0) (void)xb_add(&bar[XB_XCNT(b.x)], 1u);
    return b;
}
__device__ __forceinline__ void xcd_barrier_complete(unsigned* bar, unsigned x, unsigned& nloc, unsigned& nx) {
    const unsigned G = gridDim.x * gridDim.y * gridDim.z;
    unsigned sum, cnt, mine, sp = 0u;
    for (;;) {
        sum = 0u; cnt = 0u; mine = 0u;
#pragma unroll
        for (unsigned j = 0; j < 16; ++j) { const unsigned c = xb_ld(&bar[XB_XCNT(j)]); sum += c; cnt += (c > 0u) ? 1u : 0u; mine = (j == x) ? c : mine; }
        if (sum == G) break;
        __builtin_amdgcn_s_sleep(1);
        if ((++sp & 255u) == 0u) { if (xb_ld(&bar[XB_TMO])) break; if (sp > XB_SPIN_CAP) { atomicAdd(&bar[XB_TMO], 1u); break; } }
    }
    nloc = mine > 0u ? mine : 1u; nx = cnt > 0u ? cnt : 1u;
}

__device__ __forceinline__ void xcd_barrier(const XcdBarrier& b) {
    asm volatile("s_waitcnt vmcnt(0)" ::: "memory");
    __syncthreads();
    if (threadIdx.x == 0) {
        unsigned* bar = b.bar;
        __builtin_amdgcn_s_waitcnt(0);
        unsigned nloc = b.st[0], nx = b.st[1];
        if (nloc == 0u) { xcd_barrier_complete(bar, b.x, nloc, nx); b.st[0] = nloc; b.st[1] = nx; }
        const unsigned old = xb_add(&bar[XB_XSUB(b.x)], 1u);
        const unsigned gen = old / nloc;
        if (old + 1u == (gen + 1u) * nloc) {
            __builtin_amdgcn_fence(__ATOMIC_RELEASE, "agent");
            asm volatile("s_waitcnt vmcnt(0)" ::: "memory");
            const unsigned og = xb_add(&bar[XB_TOP], 1u);
            const unsigned tg = og / nx;
            if (og + 1u == (tg + 1u) * nx) xb_add(&bar[XB_TOPGEN], 1u);
            else XB_SPIN(xb_ld(&bar[XB_TOPGEN]) == tg, bar);
            __builtin_amdgcn_fence(__ATOMIC_ACQUIRE, "agent");
            xb_add(&bar[XB_XGEN(b.x)], 1u);
            asm volatile("s_waitcnt vmcnt(0)" ::: "memory");
        } else {
            XB_SPIN(xb_ld(&bar[XB_XGEN(b.x)]) == gen, bar);
            __builtin_amdgcn_fence(__ATOMIC_ACQUIRE, "agent");
            asm volatile("s_waitcnt vmcnt(0)" ::: "memory");
        }
    }
    __syncthreads();
}


enum { PH_PRO = 0, PH_NORM1, PH_GIN_E, PH_POST_E, PH_FOX, PH_GIN_O, PH_POST_O, PH_NSA, PH_GOUT, PH_NORM2, PH_GQ, PH_SEL, PH_PEER, PH_PEERB };

template <int PH>
__device__ __forceinline__ void run_phase(const P& p, int layer, char* lds, int wv) {
    if (PH == PH_PRO) phase_prologue(p, lds, wv);
    else if (PH == PH_NORM1) phase_norm(p, layer, 0, wv);
    else if (PH == PH_GIN_E) phase_gemm<0>(p, layer, lds, wv);
    else if (PH == PH_POST_E) phase_post_even(p, layer, wv);
    else if (PH == PH_FOX) phase_fox(p, layer, wv);
    else if (PH == PH_GIN_O) phase_gemm<1>(p, layer, lds, wv);
    else if (PH == PH_POST_O) phase_post_odd(p, layer, lds, wv);
    else if (PH == PH_NSA) phase_nsa(p, layer, lds, wv);
    else if (PH == PH_GOUT) phase_gemm<2>(p, layer, lds, wv);
    else if (PH == PH_NORM2) phase_norm2(p, layer, wv);
    else if (PH == PH_GQ) phase_gemm<3>(p, layer, lds, wv);
    else if (PH == PH_SEL) phase_peer_sel(p, layer, lds, wv);
    else if (PH == PH_PEER) phase_peer_a(p, layer, lds, wv);
    else if (PH == PH_PEERB) phase_peer_b6(p, layer, wv);
}

template <int PH>
__global__ void __launch_bounds__(NTHR, 2) k_phase(P p, int layer) {
    __shared__ __attribute__((aligned(16))) char lds[(PH == PH_PRO || PH == PH_NSA || PH == PH_SEL || PH == PH_GIN_E || PH == PH_GIN_O || PH == PH_GOUT || PH == PH_GQ || PH == PH_POST_O || PH == PH_PEER) ? LDS_BYTES : 16];
    run_phase<PH>(p, layer, lds, __builtin_amdgcn_readfirstlane(threadIdx.x >> 6));
}

#ifdef DBG_CHECK
__global__ void k_check(const void* buf, int isbf, size_t rows, int ld, int c0, int nc, int stage, unsigned* flag) {
    bool bad = false;
    const size_t n = rows * (size_t)nc;
    for (size_t i = (size_t)blockIdx.x * blockDim.x + threadIdx.x; i < n; i += (size_t)gridDim.x * blockDim.x) {
        const size_t r = i / nc; const int c = (int)(i - r * nc) + c0;
        float v = isbf ? __uint_as_float(((unsigned)((const bf16_t*)buf)[r * ld + c]) << 16) : ((const float*)buf)[r * ld + c];
        if (!(fabsf(v) < 1e30f)) bad = true;
    }
    if (bad) atomicMax(flag, (unsigned)(1000 - stage));
}
__global__ void k_report(float* o, size_t n, const unsigned* flag) {
    const unsigned f = *flag; const float v = f ? ldexpf(1.f, 1000 - (int)f) : 0.5f;
    for (size_t i = (size_t)blockIdx.x * blockDim.x + threadIdx.x; i < n; i += (size_t)gridDim.x * blockDim.x) o[i] = v;
}
#endif
__global__ void __launch_bounds__(NTHR, 2) k_mega(P p) {
    __shared__ __attribute__((aligned(16))) char lds[LDS_BYTES + 16];
    if (threadIdx.x == 0) *(uint4*)(lds + LDS_BYTES) = make_uint4(0u, 0u, 0u, 0u);
    __syncthreads();
    const int wv = __builtin_amdgcn_readfirstlane(threadIdx.x >> 6);
    (void)xcd_barrier_post(p.bar, (volatile LAS unsigned*)(lds + LDS_BYTES));
#define GRID_BARRIER() do { XcdBarrier b_; b_.bar = p.bar; b_.x = xb_xcc_id(); b_.st = (volatile LAS unsigned*)(lds + LDS_BYTES); xcd_barrier(b_); } while (0)
    run_phase<PH_PRO>(p, 0, lds, wv); GRID_BARRIER(); if (PROBE_REP & 1) { run_phase<PH_PRO>(p, 0, lds, wv); GRID_BARRIER(); }
#define MK_LAYER(layer) do { \
        run_phase<PH_NORM1>(p, layer, lds, wv); GRID_BARRIER(); if (PROBE_REP & (1 << PH_NORM1)) { run_phase<PH_NORM1>(p, layer, lds, wv); GRID_BARRIER(); } \
        if ((layer & 1) == 0) { \
            run_phase<PH_GIN_E>(p, layer, lds, wv); GRID_BARRIER(); if (PROBE_REP & (1 << PH_GIN_E)) { run_phase<PH_GIN_E>(p, layer, lds, wv); GRID_BARRIER(); } \
            run_phase<PH_POST_E>(p, layer, lds, wv); GRID_BARRIER(); \
            run_phase<PH_FOX>(p, layer, lds, wv); GRID_BARRIER(); if (PROBE_REP & (1 << PH_FOX)) { run_phase<PH_FOX>(p, layer, lds, wv); GRID_BARRIER(); } \
        } else { \
            run_phase<PH_GIN_O>(p, layer, lds, wv); GRID_BARRIER(); if (PROBE_REP & (1 << PH_GIN_O)) { run_phase<PH_GIN_O>(p, layer, lds, wv); GRID_BARRIER(); } \
            run_phase<PH_POST_O>(p, layer, lds, wv); GRID_BARRIER(); \
            run_phase<PH_NSA>(p, layer, lds, wv); GRID_BARRIER(); if (PROBE_REP & (1 << PH_NSA)) { run_phase<PH_NSA>(p, layer, lds, wv); GRID_BARRIER(); } \
        } \
        run_phase<PH_GOUT>(p, layer, lds, wv); GRID_BARRIER(); \
        run_phase<PH_NORM2>(p, layer, lds, wv); GRID_BARRIER(); if (PROBE_REP & (1 << PH_NORM2)) { run_phase<PH_NORM2>(p, layer, lds, wv); GRID_BARRIER(); } \
        run_phase<PH_GQ>(p, layer, lds, wv); GRID_BARRIER(); if (PROBE_REP & (1 << PH_GQ)) { run_phase<PH_GQ>(p, layer, lds, wv); GRID_BARRIER(); } \
        run_phase<PH_SEL>(p, layer, lds, wv); GRID_BARRIER(); if (PROBE_REP & (1 << PH_SEL)) { run_phase<PH_SEL>(p, layer, lds, wv); GRID_BARRIER(); } \
        if (PROBE_GHOST & 1) { phase_peer_a<1>(p, layer, lds, wv); GRID_BARRIER(); } \
        run_phase<PH_PEER>(p, layer, lds, wv); GRID_BARRIER(); if (PROBE_GHOST & 2) { phase_peer_b6<1>(p, layer, wv); GRID_BARRIER(); } if (PROBE_REP & (1 << PH_PEER)) { run_phase<PH_PEER>(p, layer, lds, wv); GRID_BARRIER(); } \
        run_phase<PH_PEERB>(p, layer, lds, wv); GRID_BARRIER(); \
} while (0)
    MK_LAYER(0); MK_LAYER(1); MK_LAYER(2); MK_LAYER(3);
}

static inline size_t al256(size_t x) { return (x + 255) & ~(size_t)255; }

extern "C" void kernel_launch(void* const* d_in, const int* in_sizes, int n_in, void* d_out, int out_size, void* d_ws, size_t ws_size, hipStream_t stream) {
    P p{};
    const float** f = (const float**)d_in;
    p.x = f[0]; p.c = f[1]; p.ada_w = f[2]; p.ada_b = f[3]; p.norm_g = f[4]; p.e_w_in = f[5]; p.e_b_f = f[6]; p.e_conv_w = f[7]; p.e_q_g = f[8]; p.e_k_g = f[9]; p.e_w_out = f[10];
    p.o_w_in = f[11]; p.o_b_gate = f[12]; p.o_q_g = f[13]; p.o_k_g = f[14]; p.o_cmp_pos = f[15]; p.o_cmp_w1 = f[16]; p.o_cmp_w2 = f[17]; p.o_w_out = f[18]; p.rel_table = f[19];
    p.p_w_q = f[20]; p.p_keys = f[21]; p.p_u = f[22]; p.p_v = f[23];
    p.out = (float*)d_out;
    char* w = (char*)d_ws; size_t off = 0;
    auto take = [&](size_t bytes) { char* r = w + off; off += al256(bytes); return r; };
    p.bar = (unsigned*)take(16384);
    p.mods = (float*)take((size_t)4 * 8 * 6144 * 4);
    const size_t zero_bytes = off;
    p.c1 = (float*)take(4 * 64 * 4);
    p.winE = (bf16_t*)take((size_t)2 * EVEN_NP * D_ * 2); p.woutE = (bf16_t*)take((size_t)2 * D_ * D_ * 2);
    p.winO = (bf16_t*)take((size_t)2 * ODD_NP * D_ * 2); p.woutO = (bf16_t*)take((size_t)2 * D_ * D_ * 2);
    p.wq = (bf16_t*)take((size_t)4 * D_ * D_ * 2); p.w1t = (bf16_t*)take((size_t)4 * 64 * 2048 * 2); p.w2t = (bf16_t*)take((size_t)4 * 64 * 64 * 2);
    p.keys16 = (bf16_t*)take((size_t)4 * 2 * 128 * 64 * 2);
    p.u8 = (unsigned char*)take((size_t)4 * 16384 * D_); p.v8 = (unsigned char*)take((size_t)4 * 16384 * D_);
    p.h = (bf16_t*)take((size_t)T_ * D_ * 2); p.proj = (bf16_t*)take((size_t)T_ * EVEN_LD * 2); p.cat = (bf16_t*)take((size_t)T_ * D_ * 2);
    p.vT = (bf16_t*)take((size_t)T_ * 512 * 2); p.kt = (bf16_t*)take((size_t)T_ * 512 * 2); p.kc = (bf16_t*)take((size_t)B_ * 4 * 128 * 64 * 2); p.vcT = (bf16_t*)take((size_t)B_ * 4 * 64 * 128 * 2);
    p.fg = (float*)take((size_t)T_ * 48 * 4); p.cum = (float*)take((size_t)64 * S_ * 4); p.gates = (float*)take((size_t)T_ * 48 * 4);
    p.qp = (float*)take((size_t)T_ * D_ * 4); p.selg = (float*)take((size_t)T_ * 128 * 4); p.wexp = (float*)take((size_t)T_ * 128 * 4); p.seli = (int*)take((size_t)T_ * 128 * 4);
    p.h8 = (unsigned char*)take((size_t)T_ * 2048); p.hinv = (float*)take((size_t)T_ * 4); p.winv = (float*)take((size_t)T_ * 4);
    if (off > ws_size) { fprintf(stderr, "kernel_launch: workspace too small (%zu > %zu)\n", off, ws_size); return; }
    (void)hipMemsetAsync(d_ws, 0, zero_bytes, stream);
    const int grid = 256;
#define LAUNCH(PH, layer) hipLaunchKernelGGL((k_phase<PH>), dim3(grid), dim3(NTHR), 0, stream, p, layer)
#ifdef DBG_CHECK
    unsigned* flag = p.bar + 4000;
#define CHK(buf, isbf, rows, ld, c0, nc, stage) hipLaunchKernelGGL(k_check, dim3(1024), dim3(256), 0, stream, (const void*)(buf), isbf, (size_t)(rows), ld, c0, nc, stage, flag)
#else
#define CHK(buf, isbf, rows, ld, c0, nc, stage)
#endif
#if !MK_MULTI
    {
        static int grid1 = 0;
        if (!grid1) {
            int dev = 0, cus = 0, per_cu = 0;
            (void)hipGetDevice(&dev);
            (void)hipDeviceGetAttribute(&cus, hipDeviceAttributeMultiprocessorCount, dev);
            (void)hipOccupancyMaxActiveBlocksPerMultiprocessor(&per_cu, (const void*)k_mega, NTHR, 0);
            if (per_cu < 1) fprintf(stderr, "kernel_launch: occupancy query reports %d blocks per CU\n", per_cu);
            grid1 = cus >= 8 ? (cus / 8) * 8 : 8;
        }
        hipLaunchKernelGGL(k_mega, dim3(grid1), dim3(NTHR), 0, stream, p);
        return;
    }
#endif
    LAUNCH(PH_PRO, 0);
    CHK(p.mods, 0, 32, 6144, 0, 6144, 1); CHK(p.c1, 0, 1, 256, 0, 256, 1);
    CHK(p.winE, 1, 2 * EVEN_NP, D_, 0, D_, 2); CHK(p.woutE, 1, 2 * D_, D_, 0, D_, 2); CHK(p.winO, 1, 2 * ODD_NP, D_, 0, D_, 2); CHK(p.woutO, 1, 2 * D_, D_, 0, D_, 2);
    CHK(p.wq, 1, 4 * D_, D_, 0, D_, 2); CHK(p.w1t, 1, 4 * 64, 2048, 0, 2048, 2); CHK(p.w2t, 1, 4 * 64, 64, 0, 64, 2);

    for (int layer = 0; layer < 4; ++layer) {
        const int sb = 4 + layer * 9;
        LAUNCH(PH_NORM1, layer); CHK(p.h, 1, T_, D_, 0, D_, sb + 0);
        if ((layer & 1) == 0) {
            LAUNCH(PH_GIN_E, layer);
#ifdef DBG_FINE
            CHK(p.proj, 1, T_, EVEN_LD, 0, 512, 5); CHK(p.proj, 1, T_, EVEN_LD, 512, 512, 6); CHK(p.proj, 1, T_, EVEN_LD, 1024, 512, 7); CHK(p.proj, 1, T_, EVEN_LD, 1536, 512, 8); CHK(p.proj, 1, T_, EVEN_LD, 2048, 512, 9);
            CHK(p.vT, 1, T_, 512, 0, 512, 10); CHK(p.fg, 0, T_, 8, 0, 8, 11);
            hipLaunchKernelGGL(k_report, dim3(1024), dim3(256), 0, stream, p.out, (size_t)T_ * D_, (const unsigned*)flag);
            return;
#endif
            CHK(p.proj, 1, T_, EVEN_LD, 0, 2560, sb + 1); CHK(p.vT, 1, T_, 512, 0, 512, sb + 1); CHK(p.fg, 0, T_, 8, 0, 8, sb + 1);
            LAUNCH(PH_POST_E, layer); CHK(p.proj, 1, T_, EVEN_LD, 0, 2560, sb + 2); CHK(p.cat, 1, T_, D_, 0, 512, sb + 2); CHK(p.cum, 0, 64, S_, 0, S_, sb + 2);
            LAUNCH(PH_FOX, layer); CHK(p.cat, 1, T_, D_, 0, D_, sb + 3);
        } else {
            LAUNCH(PH_GIN_O, layer); CHK(p.proj, 1, T_, ODD_LD, 0, 1792, sb + 1); CHK(p.proj, 1, T_, ODD_LD, 2048, 256, sb + 1); CHK(p.vT, 1, T_, 512, 0, 512, sb + 1); CHK(p.fg, 0, T_, 48, 0, 48, sb + 1);
            LAUNCH(PH_POST_O, layer); CHK(p.proj, 1, T_, ODD_LD, 0, 1792, sb + 2); CHK(p.proj, 1, T_, ODD_LD, 2048, 256, sb + 2); CHK(p.gates, 0, T_, 48, 0, 48, sb + 2);
            CHK(p.kc, 1, 32 * 128, 64, 0, 64, sb + 2); CHK(p.vcT, 1, 32 * 64, 128, 0, 128, sb + 2);
            LAUNCH(PH_NSA, layer); CHK(p.cat, 1, T_, D_, 0, D_, sb + 3);
        }
        LAUNCH(PH_GOUT, layer); CHK(p.out, 0, T_, D_, 0, D_, sb + 4);
        LAUNCH(PH_NORM2, layer); CHK(p.h, 1, T_, D_, 0, D_, sb + 5);
        LAUNCH(PH_GQ, layer); CHK(p.qp, 0, T_, D_, 0, D_, sb + 6);
        LAUNCH(PH_SEL, layer); CHK(p.selg, 0, T_, 128, 0, 128, sb + 7);
        LAUNCH(PH_PEER, layer); LAUNCH(PH_PEERB, layer); CHK(p.out, 0, T_, D_, 0, D_, sb + 8);
    }
#ifdef DBG_CHECK
    hipLaunchKernelGGL(k_report, dim3(1024), dim3(256), 0, stream, p.out, (size_t)T_ * D_, (const unsigned*)flag);
#endif
}
```
